# Optimizing an MI355X kernel written in HIP

```python
import math
import jax, jax.numpy as jnp
from jax import lax
import numpy as np

D_MODEL = 1024
BATCH = 8
SEQ = 2048
DEPTH = 2
DEC_BATCH = 128
DEC_SEQ = 4
PAST_LEN = 16384
PAGE_SIZE = 128

N_MIXERS = 2
N_GLA_LAYERS = (DEPTH + 1) // 2
N_S5_LAYERS = DEPTH // 2
GLA_HEADS = 4
GLA_DK = D_MODEL // 2 // GLA_HEADS
GLA_DV = D_MODEL // GLA_HEADS
GLA_QK = GLA_HEADS * GLA_DK
GLA_V = GLA_HEADS * GLA_DV
GLA_GATE_RANK = 16
GLA_GATE_TAU = 16.0
GLA_CHUNK = 64
GLA_IN = 2 * GLA_QK + 2 * GLA_V + GLA_GATE_RANK
S5_GROUP = 16
S5_GROUPS = D_MODEL // S5_GROUP
S5_STATE = 64
D_FF = 4 * D_MODEL
EPS = 1e-6

kernel_name = "gla_s5_interleaved_decoder_step"


def _rmsnorm(x, g):
    xf = x.astype(jnp.float32)
    y = xf * lax.rsqrt(jnp.mean(xf * xf, axis=-1, keepdims=True) + EPS)
    return (y * g.astype(jnp.float32)).astype(x.dtype)


def _gla_chunked(q, k, v, g, h0):
    b_, l_ = q.shape[0], q.shape[1]
    c = math.gcd(l_, GLA_CHUNK)
    n = l_ // c

    def chunks(t):
        return t.astype(jnp.float32).reshape(b_, n, c, GLA_HEADS, t.shape[-1]).transpose(1, 0, 3, 2, 4)

    q, k, v, g = chunks(q), chunks(k), chunks(v), chunks(g)
    bcum = jnp.cumsum(g, axis=3)
    b_last = bcum[..., -1:, :]
    b_ref = bcum[..., c // 2:c // 2 + 1, :]
    q_in = q * jnp.exp(bcum - b_ref)
    k_in = k * jnp.exp(b_ref - bcum)
    mask = jnp.tril(jnp.ones((c, c), dtype=bool))
    att = jnp.where(mask, jnp.einsum('nbhtk,nbhsk->nbhts', q_in, k_in), 0.0)
    o_intra = jnp.einsum('nbhts,nbhsv->nbhtv', att, v)
    u = jnp.einsum('nbhsk,nbhsv->nbhkv', k * jnp.exp(b_last - bcum), v)
    decay = jnp.exp(b_last[..., 0, :])

    def step(h, inp):
        d, uu = inp
        return d[..., None] * h + uu, h

    h_final, h_prev = lax.scan(step, h0.astype(jnp.float32), (decay, u))
    o_inter = jnp.einsum('nbhtk,nbhkv->nbhtv', q * jnp.exp(bcum), h_prev)
    o = (o_intra + o_inter).transpose(1, 0, 3, 2, 4).reshape(b_, l_, GLA_HEADS, GLA_DV)
    return o, h_final


def _gla_mixer(xn, h0, w_in, w_gate_up, b_gate, g_head, w_out):
    b_, l_, _ = xn.shape
    proj = xn @ w_in
    q, k, v, r, gl = jnp.split(proj, [GLA_QK, 2 * GLA_QK, 2 * GLA_QK + GLA_V, 2 * GLA_QK + 2 * GLA_V], axis=-1)
    gk = jax.nn.log_sigmoid((gl @ w_gate_up + b_gate).astype(jnp.float32)) / GLA_GATE_TAU
    q = q.reshape(b_, l_, GLA_HEADS, GLA_DK) * (GLA_DK ** -0.5)
    k = k.reshape(b_, l_, GLA_HEADS, GLA_DK)
    v = v.reshape(b_, l_, GLA_HEADS, GLA_DV)
    gk = gk.reshape(b_, l_, GLA_HEADS, GLA_DK)
    o, h = _gla_chunked(q, k, v, gk, h0)
    o = _rmsnorm(o, g_head.reshape(GLA_HEADS, GLA_DV)).reshape(b_, l_, GLA_V).astype(xn.dtype)
    o = o * jax.nn.silu(r)
    return o @ w_out, h.astype(h0.dtype)


def _s5_mixer(xn, h0_re, h0_im, w_in, a_re, a_im, log_step, b_re, b_im, c_re, c_im, d_skip, w_glu_a, w_glu_b):
    b_, l_, _ = xn.shape
    u = (xn @ w_in).astype(jnp.float32)
    ug = u.reshape(b_, l_, S5_GROUPS, S5_GROUP)
    ar, ai = a_re.astype(jnp.float32), a_im.astype(jnp.float32)
    dt = jnp.exp(log_step.astype(jnp.float32))[:, None]
    mag = jnp.exp(ar * dt)
    lam_re, lam_im = mag * jnp.cos(ai * dt), mag * jnp.sin(ai * dt)
    nr, ni = lam_re - 1.0, lam_im
    den = ar * ar + ai * ai
    z_re = (nr * ar + ni * ai) / den
    z_im = (ni * ar - nr * ai) / den
    br, bi = b_re.astype(jnp.float32), b_im.astype(jnp.float32)
    bb_re = z_re[..., None] * br - z_im[..., None] * bi
    bb_im = z_re[..., None] * bi + z_im[..., None] * br
    bu_re = jnp.einsum('blgc,gpc->lbgp', ug, bb_re)
    bu_im = jnp.einsum('blgc,gpc->lbgp', ug, bb_im)
    h0r, h0i = h0_re.astype(jnp.float32), h0_im.astype(jnp.float32)
    bu_re = bu_re.at[0].add(lam_re * h0r - lam_im * h0i)
    bu_im = bu_im.at[0].add(lam_re * h0i + lam_im * h0r)
    lam_re_t = jnp.broadcast_to(lam_re, (l_, 1, S5_GROUPS, S5_STATE))
    lam_im_t = jnp.broadcast_to(lam_im, (l_, 1, S5_GROUPS, S5_STATE))

    def combine(e1, e2):
        a1r, a1i, b1r, b1i = e1
        a2r, a2i, b2r, b2i = e2
        return (a1r * a2r - a1i * a2i,
                a1r * a2i + a1i * a2r,
                a2r * b1r - a2i * b1i + b2r,
                a2r * b1i + a2i * b1r + b2i)

    _, _, h_re, h_im = lax.associative_scan(combine, (lam_re_t, lam_im_t, bu_re, bu_im), axis=0)
    y = (jnp.einsum('lbgp,gcp->blgc', h_re, c_re.astype(jnp.float32))
         - jnp.einsum('lbgp,gcp->blgc', h_im, c_im.astype(jnp.float32))).reshape(b_, l_, D_MODEL)
    y = y + d_skip.astype(jnp.float32) * u
    z = jax.nn.gelu(y).astype(xn.dtype)
    out = (z @ w_glu_a) * jax.nn.sigmoid(z @ w_glu_b)
    return out, h_re[-1].astype(h0_re.dtype), h_im[-1].astype(h0_im.dtype)


def _trunk(x, gla_h0, s5_h0_re, s5_h0_im, prm):
    gla_states, s5_re, s5_im = [], [], []
    for i in range(DEPTH):
        j = i // N_MIXERS
        h = _rmsnorm(x, prm['g_pre_mix'][i])
        if i % N_MIXERS == 0:
            m, st = _gla_mixer(h, gla_h0[j], prm['gla_w_in'][j], prm['gla_w_gate_up'][j], prm['gla_b_gate'][j],
                               prm['gla_g_head'][j], prm['gla_w_out'][j])
            gla_states.append(st)
        else:
            m, sr, si = _s5_mixer(h, s5_h0_re[j], s5_h0_im[j], prm['s5_w_in'][j], prm['s5_a_re'][j], prm['s5_a_im'][j],
                                  prm['s5_log_step'][j], prm['s5_b_re'][j], prm['s5_b_im'][j], prm['s5_c_re'][j],
                                  prm['s5_c_im'][j], prm['s5_d'][j], prm['s5_w_glu_a'][j], prm['s5_w_glu_b'][j])
            s5_re.append(sr)
            s5_im.append(si)
        x = x + _rmsnorm(m, prm['g_post_mix'][i])
        h = _rmsnorm(x, prm['g_pre_mlp'][i])
        f = jnp.square(jax.nn.relu(h @ prm['w_up'][i])) @ prm['w_down'][i]
        x = x + _rmsnorm(f, prm['g_post_mlp'][i])
    return x, jnp.stack(gla_states), jnp.stack(s5_re), jnp.stack(s5_im)


def setup_inputs(seed: int = 0) -> dict:
    key = jax.random.key(seed)
    ks = jax.random.split(key, 32)
    nrm = lambda k, shape, s: jax.random.normal(k, shape, jnp.float32) * s
    n_idx = jnp.arange(S5_STATE, dtype=jnp.float32)
    return {
        'x_prompt': nrm(ks[0], (BATCH, SEQ, D_MODEL), 1.0),
        'x_sample': nrm(ks[1], (DEC_BATCH, DEC_SEQ, D_MODEL), 1.0),
        'state_gla': nrm(ks[2], (N_GLA_LAYERS, DEC_BATCH, GLA_HEADS, GLA_DK, GLA_DV), 0.5),
        'state_s5_re': nrm(ks[3], (N_S5_LAYERS, DEC_BATCH, S5_GROUPS, S5_STATE), 0.1),
        'state_s5_im': nrm(ks[4], (N_S5_LAYERS, DEC_BATCH, S5_GROUPS, S5_STATE), 0.1),
        'g_pre_mix': 1.0 + nrm(ks[5], (DEPTH, D_MODEL), 0.02),
        'g_post_mix': 1.0 + nrm(ks[6], (DEPTH, D_MODEL), 0.02),
        'g_pre_mlp': 1.0 + nrm(ks[7], (DEPTH, D_MODEL), 0.02),
        'g_post_mlp': 1.0 + nrm(ks[8], (DEPTH, D_MODEL), 0.02),
        'w_up': nrm(ks[9], (DEPTH, D_MODEL, D_FF), D_MODEL ** -0.5),
        'w_down': nrm(ks[10], (DEPTH, D_FF, D_MODEL), D_FF ** -0.5),
        'gla_w_in': nrm(ks[11], (N_GLA_LAYERS, D_MODEL, GLA_IN), D_MODEL ** -0.5),
        'gla_w_gate_up': nrm(ks[12], (N_GLA_LAYERS, GLA_GATE_RANK, GLA_QK), GLA_GATE_RANK ** -0.5),
        'gla_b_gate': nrm(ks[13], (N_GLA_LAYERS, GLA_QK), 0.1),
        'gla_g_head': 1.0 + nrm(ks[14], (N_GLA_LAYERS, GLA_V), 0.02),
        'gla_w_out': nrm(ks[15], (N_GLA_LAYERS, GLA_V, D_MODEL), GLA_V ** -0.5),
        's5_w_in': nrm(ks[16], (N_S5_LAYERS, D_MODEL, D_MODEL), D_MODEL ** -0.5),
        's5_a_re': -0.5 + nrm(ks[17], (N_S5_LAYERS, S5_GROUPS, S5_STATE), 0.01),
        's5_a_im': jnp.pi * n_idx + nrm(ks[18], (N_S5_LAYERS, S5_GROUPS, S5_STATE), 0.01),
        's5_log_step': jax.random.uniform(ks[19], (N_S5_LAYERS, S5_GROUPS), jnp.float32, math.log(1e-3), math.log(1e-1)),
        's5_b_re': nrm(ks[20], (N_S5_LAYERS, S5_GROUPS, S5_STATE, S5_GROUP), (2 * S5_GROUP) ** -0.5),
        's5_b_im': nrm(ks[21], (N_S5_LAYERS, S5_GROUPS, S5_STATE, S5_GROUP), (2 * S5_GROUP) ** -0.5),
        's5_c_re': nrm(ks[22], (N_S5_LAYERS, S5_GROUPS, S5_GROUP, S5_STATE), S5_STATE ** -0.5),
        's5_c_im': nrm(ks[23], (N_S5_LAYERS, S5_GROUPS, S5_GROUP, S5_STATE), S5_STATE ** -0.5),
        's5_d': nrm(ks[24], (N_S5_LAYERS, D_MODEL), 1.0),
        's5_w_glu_a': nrm(ks[25], (N_S5_LAYERS, D_MODEL, D_MODEL), D_MODEL ** -0.5),
        's5_w_glu_b': nrm(ks[26], (N_S5_LAYERS, D_MODEL, D_MODEL), D_MODEL ** -0.5),
    }


def reference(x_prompt, x_sample, state_gla, state_s5_re, state_s5_im, g_pre_mix, g_post_mix, g_pre_mlp, g_post_mlp,
              w_up, w_down, gla_w_in, gla_w_gate_up, gla_b_gate, gla_g_head, gla_w_out, s5_w_in, s5_a_re, s5_a_im,
              s5_log_step, s5_b_re, s5_b_im, s5_c_re, s5_c_im, s5_d, s5_w_glu_a, s5_w_glu_b):
    prm = {
        'g_pre_mix': g_pre_mix, 'g_post_mix': g_post_mix, 'g_pre_mlp': g_pre_mlp, 'g_post_mlp': g_post_mlp,
        'w_up': w_up, 'w_down': w_down,
        'gla_w_in': gla_w_in, 'gla_w_gate_up': gla_w_gate_up, 'gla_b_gate': gla_b_gate,
        'gla_g_head': gla_g_head, 'gla_w_out': gla_w_out,
        's5_w_in': s5_w_in, 's5_a_re': s5_a_re, 's5_a_im': s5_a_im, 's5_log_step': s5_log_step,
        's5_b_re': s5_b_re, 's5_b_im': s5_b_im, 's5_c_re': s5_c_re, 's5_c_im': s5_c_im, 's5_d': s5_d,
        's5_w_glu_a': s5_w_glu_a, 's5_w_glu_b': s5_w_glu_b,
    }
    b_p = x_prompt.shape[0]
    gla0 = jnp.zeros((N_GLA_LAYERS, b_p, GLA_HEADS, GLA_DK, GLA_DV), x_prompt.dtype)
    s50 = jnp.zeros((N_S5_LAYERS, b_p, S5_GROUPS, S5_STATE), x_prompt.dtype)
    y_prompt, gla_prompt, s5_re_prompt, s5_im_prompt = _trunk(x_prompt, gla0, s50, s50, prm)
    y_sample, gla_sample, s5_re_sample, s5_im_sample = _trunk(x_sample, state_gla, state_s5_re, state_s5_im, prm)
    return (y_prompt, y_sample, gla_prompt, gla_sample, s5_re_prompt, s5_im_prompt, s5_re_sample, s5_im_sample)
```

```cpp
#include <hip/hip_runtime.h>
#include <hip/hip_cooperative_groups.h>
#include <cstdio>
namespace cg = cooperative_groups;

#ifndef ONE_LAUNCH
#define ONE_LAUNCH 1
#endif

typedef unsigned short bf16_t;
typedef short bf16x8 __attribute__((ext_vector_type(8)));
typedef float f32x4 __attribute__((ext_vector_type(4)));
typedef unsigned u32x4 __attribute__((ext_vector_type(4)));
typedef unsigned u32x2 __attribute__((ext_vector_type(2)));

constexpr int TP = 16384;
constexpr int T = 16896;
constexpr int PS = 3328;
#define LAS __attribute__((address_space(3)))
constexpr int LDS_BYTES = 131072 + 16;
constexpr float EPS = 1e-6f;
constexpr int NPHASE = 17;

constexpr size_t OFF_Y = 0;
constexpr size_t OFF_GLA_P = 17301504;
constexpr size_t OFF_GLA_S = 18350080;
constexpr size_t OFF_S5RP = 35127296;
constexpr size_t OFF_S5IP = 35160064;
constexpr size_t OFF_S5RS = 35192832;
constexpr size_t OFF_S5IS = 35717120;

struct Params {
  const float *x_prompt, *x_sample, *state_gla, *s5_re, *s5_im;
  const float *g_pre_mix, *g_post_mix, *g_pre_mlp, *g_post_mlp;
  const float *w_up, *w_down, *gla_w_in, *gla_w_gate_up, *gla_b_gate, *gla_g_head, *gla_w_out;
  const float *s5_w_in, *s5_a_re, *s5_a_im, *s5_log_step, *s5_b_re, *s5_b_im, *s5_c_re, *s5_c_im, *s5_d, *s5_glu_a, *s5_glu_b;
  float* out;
  bf16_t *wt_gla_in, *wt_gla_out, *wt_up, *wt_down, *wt_s5_in, *wt_glu;
  float *lam, *bb;
  bf16_t* a1;
  char* big;
  unsigned* bar;
  bf16_t* xr;
  int phase_lo, phase_hi;
};

typedef float f32x2 __attribute__((ext_vector_type(2)));
typedef __bf16 bf16x2_t __attribute__((ext_vector_type(2)));
__device__ __forceinline__ unsigned cvt_pk_bf16(float lo, float hi) {
  const f32x2 v = {lo, hi};
  const bf16x2_t b = __builtin_convertvector(v, bf16x2_t);
  return __builtin_bit_cast(unsigned, b);
}
__device__ __forceinline__ float bf2f(bf16_t v) { return __uint_as_float(((unsigned)v) << 16); }
__device__ __forceinline__ float bflo(unsigned w) { return __uint_as_float(w << 16); }
__device__ __forceinline__ float bfhi(unsigned w) { return __uint_as_float(w & 0xffff0000u); }
__device__ __forceinline__ bf16_t f2bf(float f) { return (bf16_t)(cvt_pk_bf16(f, 0.f) & 0xffffu); }

__device__ __forceinline__ float wave_sum(float v) {
  v += __shfl_xor(v, 32); v += __shfl_xor(v, 16); v += __shfl_xor(v, 8);
  v += __shfl_xor(v, 4);  v += __shfl_xor(v, 2);  v += __shfl_xor(v, 1);
  return v;
}
__device__ __forceinline__ void lds_fence() { asm volatile("s_waitcnt lgkmcnt(0)" ::: "memory"); }

__device__ void transpose_tiles(const Params& p, char* smem) {
  const int sub = threadIdx.x >> 8, tid = threadIdx.x & 255;
  float* ts = (float*)(smem + sub * 32768);
  for (int base = blockIdx.x * 2; base < 5952; base += gridDim.x * 2) {
    int t = base + sub; const float* src; int ld, K, nvalid; bf16_t* dst; int glu = 0;
    if (t < 832) { src = p.gla_w_in; ld = 3088; K = 1024; nvalid = 3088; dst = p.wt_gla_in; }
    else if ((t -= 832) < 256) { src = p.gla_w_out; ld = 1024; K = 1024; nvalid = 1024; dst = p.wt_gla_out; }
    else if ((t -= 256) < 2048) { int l = t >> 10; t &= 1023; src = p.w_up + (size_t)l * 1024 * 4096; ld = 4096; K = 1024; nvalid = 4096; dst = p.wt_up + (size_t)l * 4096 * 1024; }
    else if ((t -= 2048) < 2048) { int l = t >> 10; t &= 1023; src = p.w_down + (size_t)l * 4096 * 1024; ld = 1024; K = 4096; nvalid = 1024; dst = p.wt_down + (size_t)l * 1024 * 4096; }
    else if ((t -= 2048) < 256) { src = p.s5_w_in; ld = 1024; K = 1024; nvalid = 1024; dst = p.wt_s5_in; }
    else { t -= 256; src = p.s5_glu_a; ld = 1024; K = 1024; nvalid = 2048; dst = p.wt_glu; glu = 1; }
    const int ktiles = K >> 6;
    const int nt = t / ktiles, kt = t - nt * ktiles;
    const int n0 = nt * 64, k0 = kt * 64;
    const int nl = tid & 63, kl = tid >> 6;
    const int n = n0 + nl;
    const float* cp = nullptr;
    if (glu) {
      const int col = (n >> 5) * 16 + (n & 15);
      cp = (((n >> 4) & 1) ? p.s5_glu_b : p.s5_glu_a) + col;
    } else if (n < nvalid) cp = src + n;
    __syncthreads();
float tv[16];
#pragma unroll
    for (int i = 0; i < 16; ++i) tv[i] = cp ? cp[(size_t)(k0 + kl + 4 * i) * ld] : 0.f;
#pragma unroll
    for (int i = 0; i < 16; ++i) ts[(kl + 4 * i) * 65 + nl] = tv[i];
    __syncthreads();
    const int k8 = (tid & 7) * 8;
#pragma unroll
    for (int i = 0; i < 2; ++i) {
      const int nn = (tid >> 3) + 32 * i;
      u32x4 w;
      w.x = cvt_pk_bf16(ts[(k8 + 0) * 65 + nn], ts[(k8 + 1) * 65 + nn]);
      w.y = cvt_pk_bf16(ts[(k8 + 2) * 65 + nn], ts[(k8 + 3) * 65 + nn]);
      w.z = cvt_pk_bf16(ts[(k8 + 4) * 65 + nn], ts[(k8 + 5) * 65 + nn]);
      w.w = cvt_pk_bf16(ts[(k8 + 6) * 65 + nn], ts[(k8 + 7) * 65 + nn]);
      *(u32x4*)(dst + (size_t)(n0 + nn) * K + k0 + k8) = w;
    }
  }
}

__device__ void s5_consts(const Params& p) {
  for (int i = blockIdx.x * 512 + threadIdx.x; i < 4096; i += gridDim.x * 512) {
    const int g = i >> 6;
    const float ar = p.s5_a_re[i], ai = p.s5_a_im[i];
    const float dt = expf(p.s5_log_step[g]);
    const float mag = expf(ar * dt);
    const float lr = mag * cosf(ai * dt), li = mag * sinf(ai * dt);
    const float nr = lr - 1.0f, ni = li;
    const float den = ar * ar + ai * ai;
    const float zr = (nr * ar + ni * ai) / den;
    const float zi = (ni * ar - nr * ai) / den;
    p.lam[i] = lr; p.lam[4096 + i] = li;
#pragma unroll
    for (int c = 0; c < 16; ++c) {
      const float br = p.s5_b_re[i * 16 + c], bi = p.s5_b_im[i * 16 + c];
      p.bb[i * 16 + c] = zr * br - zi * bi;
      p.bb[65536 + i * 16 + c] = zr * bi + zi * br;
    }
  }
}

__device__ void norm0_rows(const Params& p) {
  const int lane = threadIdx.x & 63, wid = threadIdx.x >> 6;
  for (int row = blockIdx.x * 8 + wid; row < T; row += gridDim.x * 8) {
    const float* xr = (row < TP) ? p.x_prompt + (size_t)row * 1024 : p.x_sample + (size_t)(row - TP) * 1024;
    f32x4 v[4]; float ss = 0.f;
#pragma unroll
    for (int i = 0; i < 4; ++i) { v[i] = *(const f32x4*)(xr + i * 256 + lane * 4); ss += v[i][0] * v[i][0] + v[i][1] * v[i][1] + v[i][2] * v[i][2] + v[i][3] * v[i][3]; }
    ss = wave_sum(ss);
    const float r = rsqrtf(ss * (1.0f / 1024.0f) + EPS);
#pragma unroll
    for (int i = 0; i < 4; ++i) {
      const f32x4 g = *(const f32x4*)(p.g_pre_mix + i * 256 + lane * 4);
      u32x2 w; w.x = cvt_pk_bf16(v[i][0] * r * g[0], v[i][1] * r * g[1]); w.y = cvt_pk_bf16(v[i][2] * r * g[2], v[i][3] * r * g[3]);
      *(u32x2*)(p.a1 + (size_t)row * 1024 + i * 256 + lane * 4) = w;
      u32x2 xw; xw.x = cvt_pk_bf16(v[i][0], v[i][1]); xw.y = cvt_pk_bf16(v[i][2], v[i][3]);
      *(u32x2*)(p.xr + (size_t)row * 1024 + i * 256 + lane * 4) = xw;
    }
  }
}

__device__ void rows_update(const Params& p, const bf16_t* msrc, const float* gpost, const float* gnext) {
  const int lane = threadIdx.x & 63, wid = threadIdx.x >> 6;
  const int nwav = gridDim.x * 8;
  f32x4 gp[4], gn[4];
#pragma unroll
  for (int i = 0; i < 4; ++i) {
    gp[i] = *(const f32x4*)(gpost + i * 256 + lane * 4);
    gn[i] = gnext ? *(const f32x4*)(gnext + i * 256 + lane * 4) : (f32x4){0.f, 0.f, 0.f, 0.f};
  }
  for (int row0 = blockIdx.x * 8 + wid; row0 < T; row0 += 2 * nwav) {
    u32x2 mw[2][4], xw[2][4]; bool ok[2];
#pragma unroll
    for (int r = 0; r < 2; ++r) {
      const int row = row0 + r * nwav; ok[r] = row < T;
      if (ok[r]) {
#pragma unroll
        for (int i = 0; i < 4; ++i) { mw[r][i] = *(const u32x2*)(msrc + (size_t)row * 1024 + i * 256 + lane * 4); xw[r][i] = *(const u32x2*)(p.xr + (size_t)row * 1024 + i * 256 + lane * 4); }
      }
    }
#pragma unroll
    for (int r = 0; r < 2; ++r) {
      if (!ok[r]) continue;
      const int row = row0 + r * nwav;
      f32x4 m[4]; float ss = 0.f;
#pragma unroll
      for (int i = 0; i < 4; ++i) {
        m[i][0] = bflo(mw[r][i].x); m[i][1] = bfhi(mw[r][i].x); m[i][2] = bflo(mw[r][i].y); m[i][3] = bfhi(mw[r][i].y);
        ss += m[i][0] * m[i][0] + m[i][1] * m[i][1] + m[i][2] * m[i][2] + m[i][3] * m[i][3];
      }
      ss = wave_sum(ss);
      const float rs = rsqrtf(ss * (1.0f / 1024.0f) + EPS);
      float ss2 = 0.f;
#pragma unroll
      for (int i = 0; i < 4; ++i) {
        const float x0 = bflo(xw[r][i].x), x1 = bfhi(xw[r][i].x), x2 = bflo(xw[r][i].y), x3 = bfhi(xw[r][i].y);
        m[i][0] = x0 + m[i][0] * rs * gp[i][0]; m[i][1] = x1 + m[i][1] * rs * gp[i][1];
        m[i][2] = x2 + m[i][2] * rs * gp[i][2]; m[i][3] = x3 + m[i][3] * rs * gp[i][3];
        ss2 += m[i][0] * m[i][0] + m[i][1] * m[i][1] + m[i][2] * m[i][2] + m[i][3] * m[i][3];
        if (gnext) {
          u32x2 w; w.x = cvt_pk_bf16(m[i][0], m[i][1]); w.y = cvt_pk_bf16(m[i][2], m[i][3]);
          *(u32x2*)(p.xr + (size_t)row * 1024 + i * 256 + lane * 4) = w;
        } else {
          *(f32x4*)(p.out + OFF_Y + (size_t)row * 1024 + i * 256 + lane * 4) = m[i];
        }
      }
      if (gnext) {
        ss2 = wave_sum(ss2);
        const float r2 = rsqrtf(ss2 * (1.0f / 1024.0f) + EPS);
#pragma unroll
        for (int i = 0; i < 4; ++i) {
          u32x2 w; w.x = cvt_pk_bf16(m[i][0] * r2 * gn[i][0], m[i][1] * r2 * gn[i][1]); w.y = cvt_pk_bf16(m[i][2] * r2 * gn[i][2], m[i][3] * r2 * gn[i][3]);
          *(u32x2*)(p.a1 + (size_t)row * 1024 + i * 256 + lane * 4) = w;
        }
      }
    }
  }
}

constexpr int G_BM = 256, G_BK = 64, G_HALF = 128, G_HTB = G_HALF * G_BK * 2;
__device__ __forceinline__ int g_lds_byte(int r, int c) { const int st = (r >> 4) * 2 + (c >> 5), rr = r & 15, cc = c & 31, ob = rr * 64 + cc * 2; return st * 1024 + (ob ^ (((ob >> 9) & 1) << 5)); }
__device__ __forceinline__ void g_stage_rc(int b, int& R, int& C) { const int st = b / 1024, sb = b % 1024, swz = sb ^ (((sb >> 9) & 1) << 5); R = (st >> 1) * 16 + swz / 64; C = (st & 1) * 32 + (swz % 64) / 2; }
struct Unit { int pm, pn; };
__device__ __forceinline__ bool g_next(int i, int nM, int nN, int nwg, int G, int c, Unit& u) {
  const long L = (long)i * G + c; if (L >= nwg) return false;
  int wgid = (int)L; { const int q = nwg / 8, r = nwg % 8, xcd = wgid % 8, off = wgid / 8; wgid = (xcd < r ? xcd * (q + 1) : r * (q + 1) + (xcd - r) * q) + off; }
  const int nig = 8 * nN, gid = wgid / nig, fm = gid * 8, gsz = (nM - fm) < 8 ? (nM - fm) : 8;
  u.pm = fm + ((wgid % nig) % gsz); u.pn = (wgid % nig) / gsz; return true;
}

template <int EPI>
__device__ __forceinline__ void gemm_epilogue(const f32x4 (&acc)[2][2][4][2], const Unit& u, int wr, int wc, int fr, int fq, void* outp, int ldo) {
  const int row0 = u.pm * G_BM + wr * 64 + fr;
#pragma unroll
  for (int ai = 0; ai < 2; ++ai)
#pragma unroll
    for (int m = 0; m < 4; ++m) {
      const size_t row = (size_t)(row0 + ai * G_HALF + m * 16);
#pragma unroll
      for (int bj = 0; bj < 2; ++bj) {
        if (EPI == 3) {
          const int col = u.pn * 128 + bj * 64 + wc * 16 + 4 * fq;
          const f32x4 a = acc[ai][bj][m][0], b = acc[ai][bj][m][1]; f32x4 o;
#pragma unroll
          for (int j = 0; j < 4; ++j) o[j] = a[j] / (1.0f + __expf(-b[j]));
          u32x2 w; w.x = cvt_pk_bf16(o[0], o[1]); w.y = cvt_pk_bf16(o[2], o[3]);
          *(u32x2*)((bf16_t*)outp + row * ldo + col) = w;
        } else if (EPI == 2) {
#pragma unroll
          for (int n = 0; n < 2; ++n) {
            const int col = u.pn * G_BM + wc * 32 + 4 * fq + bj * G_HALF + n * 16;
            *(f32x4*)((float*)outp + row * ldo + col) = acc[ai][bj][m][n];
          }
        } else {
          const int col = u.pn * G_BM + wc * 32 + 8 * fq + bj * G_HALF;
          f32x4 v0 = acc[ai][bj][m][0], v1 = acc[ai][bj][m][1];
          if (EPI == 1) {
#pragma unroll
            for (int j = 0; j < 4; ++j) { const float t0 = fmaxf(v0[j], 0.f), t1 = fmaxf(v1[j], 0.f); v0[j] = t0 * t0; v1[j] = t1 * t1; }
          }
          u32x4 w; w.x = cvt_pk_bf16(v0[0], v0[1]); w.y = cvt_pk_bf16(v0[2], v0[3]); w.z = cvt_pk_bf16(v1[0], v1[1]); w.w = cvt_pk_bf16(v1[2], v1[3]);
          *(u32x4*)((bf16_t*)outp + row * ldo + col) = w;
        }
      }
    }
}

template <int EPI>
__device__ __forceinline__ void gemm_phase(LAS unsigned char* lds, const bf16_t* gA, const bf16_t* gBt, const int M, const int N, const int K, void* outp, const int ldo) {
  const int tid = threadIdx.x, wid = __builtin_amdgcn_readfirstlane(tid >> 6), lane = tid & 63, wr = wid >> 2, wc = wid & 3, fr = lane & 15, fq = lane >> 4;
  const int nt = K / G_BK;
  const int nM = M / G_BM, nN = N / G_BM, nwg = nM * nN, G = (int)gridDim.x, c = (int)blockIdx.x;
  constexpr bool PERM = (EPI == 0 || EPI == 1);
  unsigned voffA[2], voffB[2];
#pragma unroll
  for (int i = 0; i < 2; ++i) { int R, C; g_stage_rc(tid * 16 + i * 8192, R, C);
    int Rb = R; if (PERM) { const int rho = R & 31, nn = rho >> 4, ii = rho & 15; Rb = (R & ~31) + 8 * (ii >> 2) + 4 * nn + (ii & 3); }
    voffA[i] = (unsigned)(R * K + C) * 2u; voffB[i] = (unsigned)(Rb * K + C) * 2u; }
  const size_t kstep = (size_t)(G_BK * 2);
  const size_t hstep = (size_t)G_HALF * K * 2;
  const size_t tstep = 2 * hstep;
  const unsigned ldsw = (unsigned)wid * 1024u;
  const int aoff = g_lds_byte(wr * 64 + fr, fq * 8), boff = g_lds_byte(wc * 32 + fr, fq * 8);
#define PG8_SA(b, h) (((b) * 2 + (h)) * G_HTB)
#define PG8_SB(b, h) ((4 + (b) * 2 + (h)) * G_HTB)
#define PG8_STAGEX(bufoff, gbase, voff) do { _Pragma("unroll") for (int _i = 0; _i < 2; ++_i) \
    __builtin_amdgcn_global_load_lds((const unsigned*)((const char*)(gbase) + (voff)[_i]), (LAS unsigned*)(lds + (bufoff) + ldsw + _i * 8192), 16, 0, 0); } while (0)
#define PG8_LDA(dst, b, h) do { _Pragma("unroll") for (int m = 0; m < 4; ++m) _Pragma("unroll") for (int k = 0; k < 2; ++k) dst[m][k] = *(const LAS bf16x8*)(lds + PG8_SA(b, h) + aoff + m * 2048 + k * 1024); } while (0)
#define PG8_LDB(dst, b, h) do { _Pragma("unroll") for (int n = 0; n < 2; ++n) _Pragma("unroll") for (int k = 0; k < 2; ++k) dst[n][k] = *(const LAS bf16x8*)(lds + PG8_SB(b, h) + boff + n * 2048 + k * 1024); } while (0)
#define PG8_MMA(ai, bj, At, Bt) do { __builtin_amdgcn_s_setprio(1); _Pragma("unroll") for (int m = 0; m < 4; ++m) _Pragma("unroll") for (int n = 0; n < 2; ++n) _Pragma("unroll") for (int k = 0; k < 2; ++k) \
    acc[ai][bj][m][n] = __builtin_amdgcn_mfma_f32_16x16x32_bf16(Bt[n][k], At[m][k], acc[ai][bj][m][n], 0, 0, 0); __builtin_amdgcn_s_setprio(0); } while (0)
#define PG8_WAIT_V(n) asm volatile("s_waitcnt vmcnt(" #n ")" ::: "memory")
#define PG8_WAIT_L(n) asm volatile("s_waitcnt lgkmcnt(" #n ")" ::: "memory")
#define PG8_BAR __builtin_amdgcn_s_barrier()
#define PG8_SCHED __builtin_amdgcn_sched_barrier(0)
  Unit cur, nxt; int ui = 0;
  if (!g_next(0, nM, nN, nwg, G, c, cur)) return;
  f32x4 acc[2][2][4][2];
#pragma unroll
  for (int a = 0; a < 2; ++a)
#pragma unroll
    for (int b = 0; b < 2; ++b)
#pragma unroll
      for (int m = 0; m < 4; ++m)
#pragma unroll
        for (int n = 0; n < 2; ++n) acc[a][b][m][n] = (f32x4){0.f, 0.f, 0.f, 0.f};
  bf16x8 At[4][2], B0[2][2], B1[2][2];
  const char* cA = (const char*)gA + (size_t)cur.pm * tstep; const char* cB = (const char*)gBt + (size_t)cur.pn * tstep;
  PG8_STAGEX(PG8_SB(0, 0), cB, voffB); PG8_STAGEX(PG8_SA(0, 0), cA, voffA); PG8_STAGEX(PG8_SB(0, 1), cB + hstep, voffB); PG8_STAGEX(PG8_SA(0, 1), cA + hstep, voffA);
  if (wr == 1) PG8_BAR;
  PG8_WAIT_V(4); PG8_BAR;
  PG8_STAGEX(PG8_SB(1, 0), cB + kstep, voffB); PG8_STAGEX(PG8_SA(1, 0), cA + kstep, voffA); PG8_STAGEX(PG8_SB(1, 1), cB + hstep + kstep, voffB);
  PG8_WAIT_V(6); PG8_BAR;
  for (;;) {
    const bool has_next = g_next(ui + 1, nM, nN, nwg, G, c, nxt);
    const char* nA = has_next ? (const char*)gA + (size_t)nxt.pm * tstep : cA; const char* nB = has_next ? (const char*)gBt + (size_t)nxt.pn * tstep : cB;
    for (int t = 0; t < nt; t += 2) {
      const bool last = (t == nt - 2);
      const char* a1 = cA + (size_t)(t + 1) * kstep;
      const char* a2 = last ? nA : cA + (size_t)(t + 2) * kstep; const char* b2 = last ? nB : cB + (size_t)(t + 2) * kstep;
      const char* a3 = a2 + kstep; const char* b3 = b2 + kstep;
      PG8_LDB(B0, 0, 0); PG8_SCHED; PG8_LDA(At, 0, 0); PG8_STAGEX(PG8_SA(1, 1), a1 + hstep, voffA);
      PG8_WAIT_L(8); PG8_BAR; PG8_WAIT_L(0); PG8_MMA(0, 0, At, B0); PG8_BAR; PG8_SCHED;
      PG8_LDB(B1, 0, 1); PG8_STAGEX(PG8_SB(0, 0), b2, voffB);
      PG8_BAR; PG8_WAIT_L(0); PG8_MMA(0, 1, At, B1); PG8_BAR;
      PG8_LDA(At, 0, 1); PG8_STAGEX(PG8_SA(0, 0), a2, voffA);
      PG8_BAR; PG8_WAIT_L(0); PG8_MMA(1, 0, At, B0); PG8_BAR; PG8_SCHED;
      PG8_STAGEX(PG8_SB(0, 1), b2 + hstep, voffB);
      PG8_WAIT_V(6); PG8_BAR; PG8_MMA(1, 1, At, B1); PG8_BAR;
      PG8_LDB(B0, 1, 0); PG8_SCHED; PG8_LDA(At, 1, 0); PG8_STAGEX(PG8_SA(0, 1), a2 + hstep, voffA);
      PG8_WAIT_L(8); PG8_BAR; PG8_WAIT_L(0); PG8_MMA(0, 0, At, B0); PG8_BAR; PG8_SCHED;
      PG8_LDB(B1, 1, 1); PG8_STAGEX(PG8_SB(1, 0), b3, voffB);
      PG8_BAR; PG8_WAIT_L(0); PG8_MMA(0, 1, At, B1); PG8_BAR;
      PG8_LDA(At, 1, 1); PG8_STAGEX(PG8_SA(1, 0), a3, voffA);
      PG8_BAR; PG8_WAIT_L(0); PG8_MMA(1, 0, At, B0); PG8_BAR; PG8_SCHED;
      PG8_STAGEX(PG8_SB(1, 1), b3 + hstep, voffB);
      PG8_WAIT_V(6); PG8_BAR; PG8_MMA(1, 1, At, B1); PG8_BAR;
    }
    gemm_epilogue<EPI>(acc, cur, wr, wc, fr, fq, outp, ldo);
    if (!has_next) break;
#pragma unroll
    for (int a = 0; a < 2; ++a)
#pragma unroll
      for (int b = 0; b < 2; ++b)
#pragma unroll
        for (int m = 0; m < 4; ++m)
#pragma unroll
          for (int n = 0; n < 2; ++n) acc[a][b][m][n] = (f32x4){0.f, 0.f, 0.f, 0.f};
    cur = nxt; cA = nA; cB = nB; ++ui;
  }
  PG8_WAIT_V(0);
  if (wr == 0) PG8_BAR;
  PG8_BAR;
#undef PG8_SA
#undef PG8_SB
#undef PG8_STAGEX
#undef PG8_LDA
#undef PG8_LDB
#undef PG8_MMA
#undef PG8_WAIT_V
#undef PG8_WAIT_L
#undef PG8_BAR
#undef PG8_SCHED
}

template <int EPI, int K, int NF = 2>
__device__ void sgemm_sample(const bf16_t* __restrict__ A, const bf16_t* __restrict__ Bt, const int N, void* outp, const int ldo, char* smem, const int blk0 = 0) {
  const int tid = threadIdx.x, lane = tid & 63, w = tid >> 6, fr = lane & 15, fq = lane >> 4;
  constexpr int TW = 16 * NF;
  float* red = (float*)smem;
  const int nitems = 8 * (N / TW);
  constexpr int KW = K / 8;
  constexpr int KB = (NF == 2) ? 128 : 64;
  const int nblk = (int)gridDim.x - blk0;
  for (int it = (int)blockIdx.x - blk0; it >= 0 && it < nitems; it += nblk) {
    const int mi = it & 7, ni = it >> 3;
    const bf16_t* Ab = A + (size_t)(TP + mi * 64 + fr) * K + w * KW + fq * 8;
    const bf16_t* Bb = Bt + (size_t)(ni * TW + fr) * K + w * KW + fq * 8;
    f32x4 acc[4][NF];
#pragma unroll
    for (int i = 0; i < 4; ++i)
#pragma unroll
      for (int j = 0; j < NF; ++j) acc[i][j] = (f32x4){0.f, 0.f, 0.f, 0.f};
#pragma unroll 1
    for (int kb = 0; kb < KW; kb += KB) {
      bf16x8 af[KB / 32][4], bfv[KB / 32][NF];
#pragma unroll
      for (int ks = 0; ks < KB / 32; ++ks) {
#pragma unroll
        for (int mf = 0; mf < 4; ++mf) af[ks][mf] = *(const bf16x8*)(Ab + (size_t)(mf * 16) * K + kb + ks * 32);
#pragma unroll
        for (int nf = 0; nf < NF; ++nf) bfv[ks][nf] = *(const bf16x8*)(Bb + (size_t)(nf * 16) * K + kb + ks * 32);
      }
#pragma unroll
      for (int ks = 0; ks < KB / 32; ++ks)
#pragma unroll
        for (int mf = 0; mf < 4; ++mf)
#pragma unroll
          for (int nf = 0; nf < NF; ++nf)
            acc[mf][nf] = __builtin_amdgcn_mfma_f32_16x16x32_bf16(bfv[ks][nf], af[ks][mf], acc[mf][nf], 0, 0, 0);
    }
    __syncthreads();
#pragma unroll
    for (int mf = 0; mf < 4; ++mf)
#pragma unroll
      for (int nf = 0; nf < NF; ++nf)
        *(f32x4*)(red + ((w * 64 + mf * 16 + fr) * TW + nf * 16 + fq * 4)) = acc[mf][nf];
    __syncthreads();
    if (EPI == 3) {
      constexpr int GPT = TW / 32;
      for (int e = tid; e < 64 * GPT * 4; e += 512) {
        const int row = e / (GPT * 4), gq = e % (GPT * 4), gi = gq >> 2, c4 = (gq & 3) * 4;
        f32x4 a = {0.f, 0.f, 0.f, 0.f}, b = {0.f, 0.f, 0.f, 0.f};
#pragma unroll
        for (int ww = 0; ww < 8; ++ww) { a += *(const f32x4*)(red + ((ww * 64 + row) * TW + gi * 32 + c4)); b += *(const f32x4*)(red + ((ww * 64 + row) * TW + gi * 32 + 16 + c4)); }
        f32x4 o;
#pragma unroll
        for (int j = 0; j < 4; ++j) o[j] = a[j] / (1.0f + __expf(-b[j]));
        u32x2 pk; pk.x = cvt_pk_bf16(o[0], o[1]); pk.y = cvt_pk_bf16(o[2], o[3]);
        *(u32x2*)((bf16_t*)outp + (size_t)(TP + mi * 64 + row) * ldo + (ni * GPT + gi) * 16 + c4) = pk;
      }
    } else {
      for (int e = tid; e < 64 * (TW / 4); e += 512) {
        const int row = e / (TW / 4), c4 = (e % (TW / 4)) * 4;
        f32x4 v = {0.f, 0.f, 0.f, 0.f};
#pragma unroll
        for (int ww = 0; ww < 8; ++ww) v += *(const f32x4*)(red + ((ww * 64 + row) * TW + c4));
        const size_t o = (size_t)(TP + mi * 64 + row) * ldo + ni * TW + c4;
        if (EPI == 2) {
          *(f32x4*)((float*)outp + o) = v;
        } else {
          if (EPI == 1) {
#pragma unroll
            for (int j = 0; j < 4; ++j) { const float t = fmaxf(v[j], 0.f); v[j] = t * t; }
          }
          u32x2 pk; pk.x = cvt_pk_bf16(v[0], v[1]); pk.y = cvt_pk_bf16(v[2], v[3]);
          *(u32x2*)((bf16_t*)outp + o) = pk;
        }
      }
    }
  }
  __syncthreads();
}

__device__ __forceinline__ float gate_decay(float z) {
  const float ls = fminf(z, 0.f) - log1pf(expf(-fabsf(z)));
  return expf(ls * 0.0625f);
}

__device__ void gla_sample_item(const Params& p, const int item, char* smem, const int tid) {
  const int h = item & 3, b = item >> 2;
  float* wg = (float*)smem;
  float* bg = wg + 2048;
  float* gl_s = bg + 128;
  float* q_s = gl_s + 64;
  float* k_s = q_s + 512;
  float* e_s = k_s + 512;
  const bf16_t* proj = (const bf16_t*)p.big;
  const int tok0 = TP + b * 4;
  __syncthreads();
  for (int i = tid; i < 2048; i += 256) { const int r = i >> 7, k = i & 127; wg[i] = p.gla_w_gate_up[r * 512 + h * 128 + k]; }
  if (tid < 128) bg[tid] = p.gla_b_gate[h * 128 + tid];
  if (tid < 64) gl_s[tid] = bf2f(proj[(size_t)(tok0 + (tid >> 4)) * PS + 3072 + (tid & 15)]);
  for (int i = tid; i < 512; i += 256) {
    const int tt = i >> 7, k = i & 127;
    q_s[i] = bf2f(proj[(size_t)(tok0 + tt) * PS + h * 128 + k]) * 0.08838834764831845f;
    k_s[i] = bf2f(proj[(size_t)(tok0 + tt) * PS + 512 + h * 128 + k]);
  }
  float vr[4];
#pragma unroll
  for (int tt = 0; tt < 4; ++tt) vr[tt] = bf2f(proj[(size_t)(tok0 + tt) * PS + 1024 + h * 256 + tid]);
  __syncthreads();
  for (int i = tid; i < 512; i += 256) {
    const int tt = i >> 7, k = i & 127;
    float z = bg[k];
#pragma unroll
    for (int r = 0; r < 16; ++r) z += gl_s[tt * 16 + r] * wg[r * 128 + k];
    e_s[i] = gate_decay(z);
  }
  __syncthreads();
  const float* sin_ = p.state_gla + ((size_t)(b * 4 + h) * 128) * 256 + tid;
  float* sout = p.out + OFF_GLA_S + ((size_t)(b * 4 + h) * 128) * 256 + tid;
  float o[4] = {0.f, 0.f, 0.f, 0.f};
  for (int kb = 0; kb < 128; kb += 16) {
    float Sv[16];
#pragma unroll
    for (int i = 0; i < 16; ++i) Sv[i] = sin_[(size_t)(kb + i) * 256];
#pragma unroll
    for (int i = 0; i < 16; ++i) {
      const int k = kb + i;
#pragma unroll
      for (int tt = 0; tt < 4; ++tt) { Sv[i] = e_s[tt * 128 + k] * Sv[i] + k_s[tt * 128 + k] * vr[tt]; o[tt] += q_s[tt * 128 + k] * Sv[i]; }
    }
#pragma unroll
    for (int i = 0; i < 16; ++i) sout[(size_t)(kb + i) * 256] = Sv[i];
  }
#pragma unroll
  for (int tt = 0; tt < 4; ++tt) p.a1[(size_t)(tok0 + tt) * 1024 + h * 256 + tid] = f2bf(o[tt]);
}


constexpr size_t KT_OFF = (size_t)T * PS * 2;
constexpr size_t VEC_OFF = KT_OFF + (size_t)16777216;

__device__ void gla_prep(const Params& p, char* smem) {
  float* gl_s = (float*)smem;
  const int c = threadIdx.x;
  bf16_t* proj = (bf16_t*)p.big;
  bf16_t* KT = (bf16_t*)(p.big + KT_OFF);
  float* VEC = (float*)(p.big + VEC_OFF);
  float wg[16];
#pragma unroll
  for (int r = 0; r < 16; ++r) wg[r] = p.gla_w_gate_up[r * 512 + c];
  const float bias = p.gla_b_gate[c];
  for (int item = blockIdx.x; item < 256; item += gridDim.x) {
    const int tok0 = (item >> 5) * 2048 + (item & 31) * 64;
    __syncthreads();
    for (int i = threadIdx.x; i < 1024; i += 512) gl_s[i] = bf2f(proj[(size_t)(tok0 + (i >> 4)) * PS + 3072 + (i & 15)]);
    __syncthreads();
    float bc[64]; float run = 0.f;
#pragma unroll
    for (int t = 0; t < 64; ++t) {
      float z = bias;
#pragma unroll
      for (int r = 0; r < 16; ++r) z += gl_s[t * 16 + r] * wg[r];
      const float ls = fminf(z, 0.f) - __logf(1.0f + __expf(-fabsf(z)));
      run += ls * 0.0625f; bc[t] = run;
    }
    const float bref = bc[32], blast = bc[63];
    bf16_t* qp = proj + (size_t)tok0 * PS + c;
    bf16_t* kp = qp + 512;
    bf16_t* ktp = KT + ((size_t)(item * 4 + (c >> 7)) * 128 + (c & 127)) * 64;
#pragma unroll
    for (int t8 = 0; t8 < 8; ++t8) {
      float kk[8];
#pragma unroll
      for (int i = 0; i < 8; ++i) {
        const int t = t8 * 8 + i;
        const float q = bf2f(qp[(size_t)t * PS]), k = bf2f(kp[(size_t)t * PS]);
        const float qi = q * 0.08838834764831845f * __expf(bc[t] - bref);
        kk[i] = k * __expf(bref - bc[t]);
        qp[(size_t)t * PS] = f2bf(qi);
        kp[(size_t)t * PS] = f2bf(kk[i]);
      }
      u32x4 w; w.x = cvt_pk_bf16(kk[0], kk[1]); w.y = cvt_pk_bf16(kk[2], kk[3]); w.z = cvt_pk_bf16(kk[4], kk[5]); w.w = cvt_pk_bf16(kk[6], kk[7]);
      *(u32x4*)(ktp + t8 * 8) = w;
    }
    VEC[(size_t)(item * 3 + 0) * 512 + c] = __expf(bref);
    VEC[(size_t)(item * 3 + 1) * 512 + c] = __expf(blast - bref);
    VEC[(size_t)(item * 3 + 2) * 512 + c] = __expf(blast);
  }
}

__device__ __forceinline__ bf16x8 lfrag(const char* base, int row, int rowbytes, int chunk, int mask) {
  return *(const bf16x8*)(base + row * rowbytes + ((chunk ^ (row & mask)) << 4));
}

struct GlaRegs { u32x4 q[2], k[2], t[2], v; float c; };

__device__ void gla_main_item(const Params& p, const int item, char* smem) {
  const int b = item >> 4, h = (item >> 2) & 3, v0 = (item & 3) * 64;
  const int tid = threadIdx.x, lane = tid & 63, w = tid >> 6, fr = lane & 15, fq = lane >> 4;
  char* Qs = smem;
  char* Ks = smem + 16384;
  char* KTs = smem + 32768;
  char* VTs = smem + 49152;
  char* ATs = smem + 57344;
  char* HTs = smem + 65536;
  float* VCs = (float*)(smem + 81920);
  const bf16_t* proj = (const bf16_t*)p.big;
  const bf16_t* KT = (const bf16_t*)(p.big + KT_OFF);
  const float* VEC = (const float*)(p.big + VEC_OFF);
  f32x4 hacc[4];
#pragma unroll
  for (int i = 0; i < 4; ++i) hacc[i] = (f32x4){0.f, 0.f, 0.f, 0.f};
  const int qrow0 = tid >> 4, qch = tid & 15;
  const int trow0 = tid >> 3, tch = tid & 7;
  const int vt_t = tid >> 3, vt_v = (tid & 7) * 8;
  auto load_regs = [&](const int n, GlaRegs& R) {
    const int tok0 = b * 2048 + n * 64, ci = b * 32 + n;
#pragma unroll
    for (int i = 0; i < 2; ++i) {
      const bf16_t* r = proj + (size_t)(tok0 + qrow0 + 32 * i) * PS + h * 128 + qch * 8;
      R.q[i] = *(const u32x4*)r; R.k[i] = *(const u32x4*)(r + 512);
      R.t[i] = *(const u32x4*)(KT + ((size_t)(ci * 4 + h) * 128 + trow0 + 64 * i) * 64 + tch * 8);
    }
    R.v = *(const u32x4*)(proj + (size_t)(tok0 + vt_t) * PS + 1024 + h * 256 + v0 + vt_v);
    R.c = (tid < 384) ? VEC[(size_t)(ci * 3 + (tid >> 7)) * 512 + h * 128 + (tid & 127)] : 0.f;
  };
  auto store_regs = [&](const GlaRegs& R) {
#pragma unroll
    for (int i = 0; i < 2; ++i) {
      const int r = qrow0 + 32 * i;
      *(u32x4*)(Qs + r * 256 + ((qch ^ (r & 15)) << 4)) = R.q[i]; *(u32x4*)(Ks + r * 256 + ((qch ^ (r & 15)) << 4)) = R.k[i];
      const int k = trow0 + 64 * i; *(u32x4*)(KTs + k * 128 + ((tch ^ (k & 7)) << 4)) = R.t[i];
    }
    const unsigned wv[4] = {R.v.x, R.v.y, R.v.z, R.v.w};
#pragma unroll
    for (int i = 0; i < 8; ++i) {
      const int v = vt_v + i;
      *(bf16_t*)(VTs + v * 128 + (((vt_t >> 3) ^ (v & 7)) << 4) + (vt_t & 7) * 2) = (bf16_t)((wv[i >> 1] >> ((i & 1) * 16)) & 0xffffu);
    }
    if (tid < 384) VCs[tid] = R.c;
  };
  auto body = [&](const int n) {
    const int tok0 = b * 2048 + n * 64;
    {
      const int k = w * 16 + fq * 4;
      const f32x4 er = *(const f32x4*)(VCs + k);
#pragma unroll
      for (int vt = 0; vt < 4; ++vt) {
        const int v = vt * 16 + fr;
        u32x2 pk; pk.x = cvt_pk_bf16(hacc[vt][0] * er[0], hacc[vt][1] * er[1]); pk.y = cvt_pk_bf16(hacc[vt][2] * er[2], hacc[vt][3] * er[3]);
        *(u32x2*)(HTs + v * 256 + (((k >> 3) ^ (v & 15)) << 4) + (k & 7) * 2) = pk;
      }
    }
    {
      const int tt = w >> 1, st0 = (w & 1) * 2;
      f32x4 d[2] = {(f32x4){0.f, 0.f, 0.f, 0.f}, (f32x4){0.f, 0.f, 0.f, 0.f}};
#pragma unroll
      for (int ks = 0; ks < 4; ++ks) {
        const bf16x8 qf = lfrag(Qs, tt * 16 + fr, 256, ks * 4 + fq, 15);
#pragma unroll
        for (int s2 = 0; s2 < 2; ++s2) {
          const bf16x8 kf = lfrag(Ks, (st0 + s2) * 16 + fr, 256, ks * 4 + fq, 15);
          d[s2] = __builtin_amdgcn_mfma_f32_16x16x32_bf16(kf, qf, d[s2], 0, 0, 0);
        }
      }
      const int t = tt * 16 + fr;
#pragma unroll
      for (int s2 = 0; s2 < 2; ++s2) {
        const int s = (st0 + s2) * 16 + fq * 4;
        const float a0 = (s + 0 <= t) ? d[s2][0] : 0.f, a1 = (s + 1 <= t) ? d[s2][1] : 0.f, a2 = (s + 2 <= t) ? d[s2][2] : 0.f, a3 = (s + 3 <= t) ? d[s2][3] : 0.f;
        u32x2 pk; pk.x = cvt_pk_bf16(a0, a1); pk.y = cvt_pk_bf16(a2, a3);
        *(u32x2*)(ATs + t * 128 + (((s >> 3) ^ (t & 7)) << 4) + (s & 7) * 2) = pk;
      }
    }
    __syncthreads();
    {
      const int tt = w >> 1, vt0 = (w & 1) * 2;
      f32x4 o[2] = {(f32x4){0.f, 0.f, 0.f, 0.f}, (f32x4){0.f, 0.f, 0.f, 0.f}};
#pragma unroll
      for (int ks = 0; ks < 2; ++ks) {
        const bf16x8 af = lfrag(ATs, tt * 16 + fr, 128, ks * 4 + fq, 7);
#pragma unroll
        for (int v2 = 0; v2 < 2; ++v2) o[v2] = __builtin_amdgcn_mfma_f32_16x16x32_bf16(lfrag(VTs, (vt0 + v2) * 16 + fr, 128, ks * 4 + fq, 7), af, o[v2], 0, 0, 0);
      }
#pragma unroll
      for (int ks = 0; ks < 4; ++ks) {
        const bf16x8 qf = lfrag(Qs, tt * 16 + fr, 256, ks * 4 + fq, 15);
#pragma unroll
        for (int v2 = 0; v2 < 2; ++v2) o[v2] = __builtin_amdgcn_mfma_f32_16x16x32_bf16(lfrag(HTs, (vt0 + v2) * 16 + fr, 256, ks * 4 + fq, 15), qf, o[v2], 0, 0, 0);
      }
#pragma unroll
      for (int v2 = 0; v2 < 2; ++v2) {
        u32x2 pk; pk.x = cvt_pk_bf16(o[v2][0], o[v2][1]); pk.y = cvt_pk_bf16(o[v2][2], o[v2][3]);
        *(u32x2*)(p.a1 + (size_t)(tok0 + tt * 16 + fr) * 1024 + h * 256 + v0 + (vt0 + v2) * 16 + fq * 4) = pk;
      }
    }
    {
      const int k = w * 16 + fq * 4;
      const f32x4 ec = *(const f32x4*)(VCs + 128 + k), dc = *(const f32x4*)(VCs + 256 + k);
      f32x4 u[4];
#pragma unroll
      for (int vt = 0; vt < 4; ++vt) u[vt] = (f32x4){0.f, 0.f, 0.f, 0.f};
#pragma unroll
      for (int ks = 0; ks < 2; ++ks) {
        const bf16x8 kf = lfrag(KTs, w * 16 + fr, 128, ks * 4 + fq, 7);
#pragma unroll
        for (int vt = 0; vt < 4; ++vt) u[vt] = __builtin_amdgcn_mfma_f32_16x16x32_bf16(kf, lfrag(VTs, vt * 16 + fr, 128, ks * 4 + fq, 7), u[vt], 0, 0, 0);
      }
#pragma unroll
      for (int vt = 0; vt < 4; ++vt)
#pragma unroll
        for (int j = 0; j < 4; ++j) hacc[vt][j] = dc[j] * hacc[vt][j] + ec[j] * u[vt][j];
    }
  };
  GlaRegs RA, RB;
  __syncthreads();
  load_regs(0, RA);
  store_regs(RA);
  __syncthreads();
  load_regs(1, RA);
  for (int n = 0; n < 32; n += 2) {
    if (n + 2 < 32) load_regs(n + 2, RB);
    body(n);
    __syncthreads();
    store_regs(RA);
    __syncthreads();
    if (n + 3 < 32) load_regs(n + 3, RA);
    body(n + 1);
    __syncthreads();
    if (n + 2 < 32) store_regs(RB);
    __syncthreads();
  }
  float* st = p.out + OFF_GLA_P + ((size_t)(b * 4 + h) * 128) * 256;
#pragma unroll
  for (int vt = 0; vt < 4; ++vt)
#pragma unroll
    for (int j = 0; j < 4; ++j) st[(size_t)(w * 16 + fq * 4 + j) * 256 + v0 + vt * 16 + fr] = hacc[vt][j];
}

__device__ void gla_phase(const Params& p, char* smem) {
  const int sub = threadIdx.x >> 8, tid = threadIdx.x & 255;
  const int G = (int)gridDim.x;
  if (G >= 256) {
    if ((int)blockIdx.x < 128) gla_main_item(p, (((int)blockIdx.x & 7) * 4 + ((int)blockIdx.x >> 5)) * 4 + (((int)blockIdx.x >> 3) & 3), smem);
    else for (int base = ((int)blockIdx.x - 128) * 2; base < 512; base += (G - 128) * 2) gla_sample_item(p, base + sub, smem + sub * 65536, tid);
  } else {
    for (int item = blockIdx.x; item < 128; item += G) gla_main_item(p, item, smem);
    for (int base = blockIdx.x * 2; base < 512; base += G * 2) gla_sample_item(p, base + sub, smem + sub * 65536, tid);
  }
}

__device__ void gla_gate_rows(const Params& p) {
  const int lane = threadIdx.x & 63, wid = threadIdx.x >> 6;
  const bf16_t* proj = (const bf16_t*)p.big;
  const int nwav = gridDim.x * 8;
  f32x4 g[4];
#pragma unroll
  for (int i = 0; i < 4; ++i) g[i] = *(const f32x4*)(p.gla_g_head + i * 256 + lane * 4);
  for (int row0 = blockIdx.x * 8 + wid; row0 < T; row0 += 2 * nwav) {
    u32x2 ow[2][4], rw[2][4]; bool ok[2];
#pragma unroll
    for (int r = 0; r < 2; ++r) {
      const int row = row0 + r * nwav; ok[r] = row < T;
      if (ok[r]) {
#pragma unroll
        for (int i = 0; i < 4; ++i) { ow[r][i] = *(const u32x2*)(p.a1 + (size_t)row * 1024 + i * 256 + lane * 4); rw[r][i] = *(const u32x2*)(proj + (size_t)row * PS + 2048 + i * 256 + lane * 4); }
      }
    }
#pragma unroll
    for (int r = 0; r < 2; ++r) {
      if (!ok[r]) continue;
      const int row = row0 + r * nwav;
#pragma unroll
      for (int i = 0; i < 4; ++i) {
        const float o[4] = {bflo(ow[r][i].x), bfhi(ow[r][i].x), bflo(ow[r][i].y), bfhi(ow[r][i].y)};
        float ss = o[0] * o[0] + o[1] * o[1] + o[2] * o[2] + o[3] * o[3];
        ss = wave_sum(ss);
        const float rs = rsqrtf(ss * (1.0f / 256.0f) + EPS);
        const float rr[4] = {bflo(rw[r][i].x), bfhi(rw[r][i].x), bflo(rw[r][i].y), bfhi(rw[r][i].y)};
        float y[4];
#pragma unroll
        for (int j = 0; j < 4; ++j) y[j] = o[j] * rs * g[i][j] * (rr[j] / (1.0f + __expf(-rr[j])));
        u32x2 w; w.x = cvt_pk_bf16(y[0], y[1]); w.y = cvt_pk_bf16(y[2], y[3]);
        *(u32x2*)(p.a1 + (size_t)row * 1024 + i * 256 + lane * 4) = w;
      }
    }
  }
}

__device__ __forceinline__ bf16x8 pack8(const float* s, float sgn) {
  const f32x4 a = *(const f32x4*)s, b = *(const f32x4*)(s + 4);
  union { u32x4 u; bf16x8 v; } r;
  r.u.x = cvt_pk_bf16(a[0] * sgn, a[1] * sgn); r.u.y = cvt_pk_bf16(a[2] * sgn, a[3] * sgn);
  r.u.z = cvt_pk_bf16(b[0] * sgn, b[1] * sgn); r.u.w = cvt_pk_bf16(b[2] * sgn, b[3] * sgn);
  return r.v;
}

struct S5Consts { bf16x8 Bb[8]; bf16x8 Cc[4]; float lr, li, dsk; };

__device__ __forceinline__ void s5_load_consts(const Params& p, const int g, const int lane, S5Consts& k) {
  const int fr = lane & 15, fq = lane >> 4;
  const bf16x8 zero8 = {0, 0, 0, 0, 0, 0, 0, 0};
#pragma unroll
  for (int nt = 0; nt < 8; ++nt) {
    const int pp = nt * 8 + (fr >> 1);
    const float* src = p.bb + ((fr & 1) ? 65536 : 0) + (size_t)(g * 64 + pp) * 16 + (fq & 1) * 8;
    const bf16x8 v = pack8(src, 1.0f);
    k.Bb[nt] = (fq < 2) ? v : zero8;
  }
#pragma unroll
  for (int ks = 0; ks < 4; ++ks) {
    const int p0 = ks * 16 + fq * 4;
    const f32x4 cr = *(const f32x4*)(p.s5_c_re + (size_t)(g * 16 + fr) * 64 + p0), ci = *(const f32x4*)(p.s5_c_im + (size_t)(g * 16 + fr) * 64 + p0);
    union { u32x4 u; bf16x8 v; } r;
    r.u.x = cvt_pk_bf16(cr[0], -ci[0]); r.u.y = cvt_pk_bf16(cr[1], -ci[1]); r.u.z = cvt_pk_bf16(cr[2], -ci[2]); r.u.w = cvt_pk_bf16(cr[3], -ci[3]);
    k.Cc[ks] = r.v;
  }
  k.lr = p.lam[g * 64 + lane]; k.li = p.lam[4096 + g * 64 + lane];
  k.dsk = p.s5_d[g * 16 + fr];
}

template <bool FULL>
__device__ __forceinline__ void s5_segment(const Params& p, const S5Consts& k, const int tok0, const int L, const int g, float& hr, float& hi,
                                           char* wl, const int lane) {
  const int fr = lane & 15, fq = lane >> 4;
  float* bu_s = (float*)wl;
  bf16_t* h_s = (bf16_t*)(wl + 8448);
  bf16_t* u_s = (bf16_t*)(wl + 12800);
  const bf16_t* u = (const bf16_t*)p.big;
  const u32x4 zero4 = {0u, 0u, 0u, 0u};
  const bf16_t* ub = u + (size_t)(tok0 + fr) * 1024 + g * 16 + (fq & 1) * 8;
#define S5_LD(c) ((fq < 2 && (c) + fr < L) ? *(const u32x4*)(ub + (size_t)(c) * 1024) : zero4)
  u32x4 q0 = S5_LD(0), q1 = S5_LD(16), q2 = S5_LD(32), q3 = S5_LD(48);
  for (int c0 = 0; c0 < L; c0 += 16) {
    const u32x4 cur = q0; q0 = q1; q1 = q2; q2 = q3; q3 = S5_LD(c0 + 64);
    union { u32x4 u4; bf16x8 v; } ua; ua.u4 = cur;
#pragma unroll
    for (int nt = 0; nt < 8; ++nt) {
      const f32x4 d = __builtin_amdgcn_mfma_f32_16x16x32_bf16(ua.v, k.Bb[nt], (f32x4){0.f, 0.f, 0.f, 0.f}, 0, 0, 0);
#pragma unroll
      for (int j = 0; j < 4; ++j) bu_s[(fq * 4 + j) * 132 + nt * 16 + fr] = d[j];
    }
    if (FULL && fq < 2) *(u32x4*)(u_s + fr * 16 + fq * 8) = cur;
    lds_fence();
    const int nsteps = (L - c0) < 16 ? (L - c0) : 16;
    f32x2 bu[16];
#pragma unroll
    for (int tt = 0; tt < 16; ++tt) bu[tt] = *(const f32x2*)(bu_s + tt * 132 + 2 * lane);
#pragma unroll
    for (int tt = 0; tt < 16; ++tt) {
      if (tt < nsteps) {
        const float nr = k.lr * hr - k.li * hi + bu[tt][0];
        const float ni = k.lr * hi + k.li * hr + bu[tt][1];
        hr = nr; hi = ni;
      }
      if (FULL) ((unsigned*)h_s)[tt * 68 + lane] = cvt_pk_bf16(hr, hi);
    }
    lds_fence();
    if (FULL) {
      f32x4 y = {0.f, 0.f, 0.f, 0.f};
#pragma unroll
      for (int ks = 0; ks < 4; ++ks) {
        const bf16x8 ha = *(const bf16x8*)(h_s + fr * 136 + ks * 32 + fq * 8);
        y = __builtin_amdgcn_mfma_f32_16x16x32_bf16(ha, k.Cc[ks], y, 0, 0, 0);
      }
#pragma unroll
      for (int j = 0; j < 4; ++j) {
        const int tt = fq * 4 + j;
        if (c0 + tt < L) {
          const float yy = y[j] + k.dsk * bf2f(u_s[tt * 16 + fr]);
          const float z = yy / (1.0f + __expf(-1.5957691216057308f * (yy + 0.044715f * yy * yy * yy)));
          p.a1[(size_t)(tok0 + c0 + tt) * 1024 + g * 16 + fr] = f2bf(z);
        }
      }
      lds_fence();
    }
  }
#undef S5_LD
}

__device__ void s5_phase(const Params& p, char* smem) {
  const int tid = threadIdx.x, lane = tid & 63, wid = tid >> 6;
  char* wl = smem + wid * 14336;
  float* carry = (float*)(smem + 114688);
  for (int pb = blockIdx.x * 2; pb < 512; pb += gridDim.x * 2) {
    const int pl = wid >> 2, seg = wid & 3, pair = pb + pl;
    const int b = pair >> 6, g = pair & 63;
    const int tok0 = b * 2048 + seg * 512;
    S5Consts k; s5_load_consts(p, g, lane, k);
    float hr = 0.f, hi = 0.f;
    s5_segment<false>(p, k, tok0, 512, g, hr, hi, wl, lane);
    __syncthreads();
    carry[((pl * 4 + seg) * 2 + 0) * 64 + lane] = hr; carry[((pl * 4 + seg) * 2 + 1) * 64 + lane] = hi;
    __syncthreads();
    float pr = k.lr, pi = k.li;
#pragma unroll
    for (int i = 0; i < 9; ++i) { const float tr = pr * pr - pi * pi, ti = 2.0f * pr * pi; pr = tr; pi = ti; }
    hr = 0.f; hi = 0.f;
    for (int s2 = 0; s2 < seg; ++s2) {
      const float fr_ = carry[((pl * 4 + s2) * 2 + 0) * 64 + lane], fi_ = carry[((pl * 4 + s2) * 2 + 1) * 64 + lane];
      const float nr = pr * hr - pi * hi + fr_, ni = pr * hi + pi * hr + fi_;
      hr = nr; hi = ni;
    }
    s5_segment<true>(p, k, tok0, 512, g, hr, hi, wl, lane);
    if (seg == 3) {
      p.out[OFF_S5RP + (size_t)(b * 64 + g) * 64 + lane] = hr; p.out[OFF_S5IP + (size_t)(b * 64 + g) * 64 + lane] = hi;
    }
    __syncthreads();
  }
  const int gw = wid * gridDim.x + blockIdx.x, nw = gridDim.x * 8;
  const bool same_g = (nw & 63) == 0;
  S5Consts ks;
  if (same_g && gw < 8192) s5_load_consts(p, gw & 63, lane, ks);
  for (int it = gw; it < 8192; it += nw) {
    const int b = it >> 6, g = it & 63;
    if (!same_g) s5_load_consts(p, g, lane, ks);
    float hr = p.s5_re[(size_t)(b * 64 + g) * 64 + lane], hi = p.s5_im[(size_t)(b * 64 + g) * 64 + lane];
    s5_segment<true>(p, ks, TP + b * 4, 4, g, hr, hi, wl, lane);
    p.out[OFF_S5RS + (size_t)(b * 64 + g) * 64 + lane] = hr; p.out[OFF_S5IS + (size_t)(b * 64 + g) * 64 + lane] = hi;
  }
}

#define XB_TMO      128
#define XB_XCNT(j)  (256  + 64 * (j))
#define XB_XSUB(j)  (1280 + 64 * (j))
#define XB_XGEN(j)  (2304 + 64 * (j))
#define XB_TOP      3328
#define XB_TOPGEN   3392
#define XCD_BAR_WORDS 3456
#define XB_SPIN_CAP (1u << 18)
__device__ __forceinline__ unsigned xb_ld(unsigned* p)              { return __hip_atomic_load(p, __ATOMIC_RELAXED, __HIP_MEMORY_SCOPE_AGENT); }
__device__ __forceinline__ unsigned xb_add(unsigned* p, unsigned v) { return __hip_atomic_fetch_add(p, v, __ATOMIC_RELAXED, __HIP_MEMORY_SCOPE_AGENT); }
__device__ __forceinline__ unsigned xb_xcc_id() { return (unsigned)__builtin_amdgcn_s_getreg((3 << 11) | 20) & 0xFu; }
#define XB_SPIN(cond, bar) do { unsigned _sp = 0; while (cond) { __builtin_amdgcn_s_sleep(1); \
    if ((++_sp & 255u) == 0u) { if (xb_ld(&(bar)[XB_TMO])) break; if (_sp > XB_SPIN_CAP) { atomicAdd(&(bar)[XB_TMO], 1u); break; } } } } while (0)
struct XcdBarrier { unsigned* bar; unsigned x; volatile LAS unsigned* st; };
__device__ __forceinline__ XcdBarrier xcd_barrier_post(unsigned* bar, volatile LAS unsigned* st) {
  XcdBarrier b; b.bar = bar; b.x = xb_xcc_id(); b.st = st;
  if (threadIdx.x == 0) (void)xb_add(&bar[XB_XCNT(b.x)], 1u);
  return b;
}
__device__ __forceinline__ void xcd_barrier_complete(unsigned* bar, unsigned x, unsigned& nloc, unsigned& nx) {
  const unsigned G = gridDim.x * gridDim.y * gridDim.z;
  unsigned sum, cnt, mine, sp = 0u;
  for (;;) {
    sum = 0u; cnt = 0u; mine = 0u;
#pragma unroll
    for (unsigned j = 0; j < 16; ++j) { const unsigned c = xb_ld(&bar[XB_XCNT(j)]); sum += c; cnt += (c > 0u) ? 1u : 0u; mine = (j == x) ? c : mine; }
    if (sum == G) break;
    __builtin_amdgcn_s_sleep(1);
    if ((++sp & 255u) == 0u) { if (xb_ld(&bar[XB_TMO])) break; if (sp > XB_SPIN_CAP) { atomicAdd(&bar[XB_TMO], 1u); break; } }
  }
  nloc = mine > 0u ? mine : 1u; nx = cnt > 0u ? cnt : 1u;
}
__device__ __forceinline__ void xcd_barrier(const XcdBarrier& b) {
  asm volatile("s_waitcnt vmcnt(0)" ::: "memory");
  __syncthreads();
  if (threadIdx.x == 0) {
    unsigned* bar = b.bar;
    __builtin_amdgcn_s_waitcnt(0);
    unsigned nloc = b.st[0], nx = b.st[1];
    if (nloc == 0u) { xcd_barrier_complete(bar, b.x, nloc, nx); b.st[0] = nloc; b.st[1] = nx; }
    const unsigned old = xb_add(&bar[XB_XSUB(b.x)], 1u);
    const unsigned gen = old / nloc;
    if (old + 1u == (gen + 1u) * nloc) {
      __builtin_amdgcn_fence(__ATOMIC_RELEASE, "agent");
      asm volatile("s_waitcnt vmcnt(0)" ::: "memory");
      const unsigned og = xb_add(&bar[XB_TOP], 1u);
      const unsigned tg = og / nx;
      if (og + 1u == (tg + 1u) * nx) xb_add(&bar[XB_TOPGEN], 1u);
      else XB_SPIN(xb_ld(&bar[XB_TOPGEN]) == tg, bar);
      __builtin_amdgcn_fence(__ATOMIC_ACQUIRE, "agent");
      xb_add(&bar[XB_XGEN(b.x)], 1u);
      asm volatile("s_waitcnt vmcnt(0)" ::: "memory");
    } else {
      XB_SPIN(xb_ld(&bar[XB_XGEN(b.x)]) == gen, bar);
      __builtin_amdgcn_fence(__ATOMIC_ACQUIRE, "agent");
      asm volatile("s_waitcnt vmcnt(0)" ::: "memory");
    }
  }
  __syncthreads();
}
#define grid_sync() xcd_barrier(xbar)

#ifndef DOUBLE_MASK
#define DOUBLE_MASK 0
#endif
#define PHASE(k, call) \
  if (p.phase_lo <= (k) && (k) < p.phase_hi) { if ((DOUBLE_MASK >> (k)) & 1) { call; grid_sync(); } call; if ((k) + 1 < p.phase_hi) grid_sync(); }

#define STAGGER(main_call, sample_call) \
  [&]() { if (blockIdx.x & 1) { sample_call; main_call; } else { main_call; sample_call; } }()

__global__ void __launch_bounds__(512, 2) mega_kernel(Params p) {
  extern __shared__ __attribute__((aligned(16))) char smem[];
  LAS unsigned char* lds = (LAS unsigned char*)smem;
  volatile LAS unsigned* xst = (volatile LAS unsigned*)(lds + 131072);
  if (threadIdx.x < 4) xst[threadIdx.x] = 0u;
  __syncthreads();
  const XcdBarrier xbar = xcd_barrier_post(p.bar, xst);
  if (p.phase_lo == 12345) cg::this_grid().sync();
  PHASE(0, (transpose_tiles(p, smem), s5_consts(p), norm0_rows(p)))
  PHASE(1, (gemm_phase<0>(lds, p.a1, p.wt_gla_in, TP, PS, 1024, p.big, PS), sgemm_sample<0, 1024>(p.a1, p.wt_gla_in, PS, p.big, PS, smem, (gridDim.x == 256) ? 64 : 0)))
  PHASE(2, (gla_prep(p, smem), __syncthreads()))
  PHASE(3, gla_phase(p, smem))
  PHASE(4, gla_gate_rows(p))
  PHASE(5, (gemm_phase<0>(lds, p.a1, p.wt_gla_out, TP, 1024, 1024, p.big, 1024), sgemm_sample<0, 1024>(p.a1, p.wt_gla_out, 1024, p.big, 1024, smem)))
  PHASE(6, rows_update(p, (const bf16_t*)p.big, p.g_post_mix, p.g_pre_mlp))
  PHASE(7, STAGGER((gemm_phase<1>(lds, p.a1, p.wt_up, TP, 4096, 1024, p.big, 4096)), (sgemm_sample<1, 1024, 4>(p.a1, p.wt_up, 4096, p.big, 4096, smem))))
  PHASE(8, (gemm_phase<0>(lds, (const bf16_t*)p.big, p.wt_down, TP, 1024, 4096, p.a1, 1024), sgemm_sample<0, 4096>((const bf16_t*)p.big, p.wt_down, 1024, p.a1, 1024, smem)))
  PHASE(9, rows_update(p, p.a1, p.g_post_mlp, p.g_pre_mix + 1024))
  PHASE(10, (gemm_phase<0>(lds, p.a1, p.wt_s5_in, TP, 1024, 1024, p.big, 1024), sgemm_sample<0, 1024>(p.a1, p.wt_s5_in, 1024, p.big, 1024, smem)))
  PHASE(11, s5_phase(p, smem))
  PHASE(12, STAGGER((gemm_phase<3>(lds, p.a1, p.wt_glu, TP, 2048, 1024, p.big, 1024)), (sgemm_sample<3, 1024, 4>(p.a1, p.wt_glu, 2048, p.big, 1024, smem))))
  PHASE(13, rows_update(p, (const bf16_t*)p.big, p.g_post_mix + 1024, p.g_pre_mlp + 1024))
  PHASE(14, STAGGER((gemm_phase<1>(lds, p.a1, p.wt_up + (size_t)4096 * 1024, TP, 4096, 1024, p.big, 4096)), (sgemm_sample<1, 1024, 4>(p.a1, p.wt_up + (size_t)4096 * 1024, 4096, p.big, 4096, smem))))
  PHASE(15, (gemm_phase<0>(lds, (const bf16_t*)p.big, p.wt_down + (size_t)4096 * 1024, TP, 1024, 4096, p.a1, 1024), sgemm_sample<0, 4096>((const bf16_t*)p.big, p.wt_down + (size_t)4096 * 1024, 1024, p.a1, 1024, smem)))
  PHASE(16, rows_update(p, p.a1, p.g_post_mlp + 1024, nullptr))
}

extern "C" void kernel_launch(void* const* d_in, const int* in_sizes, int n_in, void* d_out, int out_size, void* d_ws,
                              size_t ws_size, hipStream_t stream) {
  (void)in_sizes; (void)n_in; (void)out_size; (void)ws_size;
  Params p{};
  p.x_prompt = (const float*)d_in[0]; p.x_sample = (const float*)d_in[1]; p.state_gla = (const float*)d_in[2];
  p.s5_re = (const float*)d_in[3]; p.s5_im = (const float*)d_in[4];
  p.g_pre_mix = (const float*)d_in[5]; p.g_post_mix = (const float*)d_in[6]; p.g_pre_mlp = (const float*)d_in[7]; p.g_post_mlp = (const float*)d_in[8];
  p.w_up = (const float*)d_in[9]; p.w_down = (const float*)d_in[10]; p.gla_w_in = (const float*)d_in[11];
  p.gla_w_gate_up = (const float*)d_in[12]; p.gla_b_gate = (const float*)d_in[13]; p.gla_g_head = (const float*)d_in[14]; p.gla_w_out = (const float*)d_in[15];
  p.s5_w_in = (const float*)d_in[16]; p.s5_a_re = (const float*)d_in[17]; p.s5_a_im = (const float*)d_in[18]; p.s5_log_step = (const float*)d_in[19];
  p.s5_b_re = (const float*)d_in[20]; p.s5_b_im = (const float*)d_in[21]; p.s5_c_re = (const float*)d_in[22]; p.s5_c_im = (const float*)d_in[23];
  p.s5_d = (const float*)d_in[24]; p.s5_glu_a = (const float*)d_in[25]; p.s5_glu_b = (const float*)d_in[26];
  p.out = (float*)d_out;
  char* ws = (char*)d_ws;
  p.wt_gla_in = (bf16_t*)(ws + 0);
  p.wt_gla_out = (bf16_t*)(ws + 6815744);
  p.wt_up = (bf16_t*)(ws + 8912896);
  p.wt_down = (bf16_t*)(ws + 25690112);
  p.wt_s5_in = (bf16_t*)(ws + 42467328);
  p.wt_glu = (bf16_t*)(ws + 44564480);
  p.lam = (float*)(ws + 48758784);
  p.bb = (float*)(ws + 48791552);
  p.a1 = (bf16_t*)(ws + 49315840);
  p.big = ws + 83918848;
  p.bar = (unsigned*)(ws + 222330880);
  p.xr = (bf16_t*)(ws + 222344704);

  static int grid_blocks = 0;
  if (!grid_blocks) {
    int dev = 0, cus = 0, per_cu = 0;
    (void)hipGetDevice(&dev);
    (void)hipDeviceGetAttribute(&cus, hipDeviceAttributeMultiprocessorCount, dev);
    (void)hipFuncSetAttribute((const void*)mega_kernel, hipFuncAttributeMaxDynamicSharedMemorySize, LDS_BYTES);
    (void)hipOccupancyMaxActiveBlocksPerMultiprocessor(&per_cu, mega_kernel, 512, LDS_BYTES);
    if (per_cu > 1) per_cu = 1;
    if (per_cu < 1) per_cu = 1;
    if (cus <= 0) cus = 256;
    grid_blocks = cus * per_cu;
  }
#if ONE_LAUNCH
  p.phase_lo = 0; p.phase_hi = NPHASE;
  (void)hipMemsetAsync(p.bar, 0, XCD_BAR_WORDS * 4, stream);
  void* args[] = {&p};
  hipError_t e = hipLaunchCooperativeKernel((void*)mega_kernel, dim3(grid_blocks), dim3(512), args, LDS_BYTES, stream);
  if (e != hipSuccess) fprintf(stderr, "cooperative launch failed: %s (grid %d)\n", hipGetErrorString(e), grid_blocks);
#endif
}
```

```cpp
#include <hip/hip_runtime.h>
#include <hip/hip_cooperative_groups.h>
#include <cstdio>
namespace cg = cooperative_groups;

#ifndef ONE_LAUNCH
#define ONE_LAUNCH 1
#endif

typedef unsigned short bf16_t;
typedef short bf16x8 __attribute__((ext_vector_type(8)));
typedef float f32x4 __attribute__((ext_vector_type(4)));
typedef unsigned u32x4 __attribute__((ext_vector_type(4)));
typedef unsigned u32x2 __attribute__((ext_vector_type(2)));

constexpr int TP = 16384;
constexpr int T = 16896;
constexpr int PS = 3328;
#define LAS __attribute__((address_space(3)))
constexpr int LDS_BYTES = 131072 + 16;
constexpr float EPS = 1e-6f;
constexpr int NPHASE = 17;

constexpr size_t OFF_Y = 0;
constexpr size_t OFF_GLA_P = 17301504;
constexpr size_t OFF_GLA_S = 18350080;
constexpr size_t OFF_S5RP = 35127296;
constexpr size_t OFF_S5IP = 35160064;
constexpr size_t OFF_S5RS = 35192832;
constexpr size_t OFF_S5IS = 35717120;

struct Params {
  const float *x_prompt, *x_sample, *state_gla, *s5_re, *s5_im;
  const float *g_pre_mix, *g_post_mix, *g_pre_mlp, *g_post_mlp;
  const float *w_up, *w_down, *gla_w_in, *gla_w_gate_up, *gla_b_gate, *gla_g_head, *gla_w_out;
  const float *s5_w_in, *s5_a_re, *s5_a_im, *s5_log_step, *s5_b_re, *s5_b_im, *s5_c_re, *s5_c_im, *s5_d, *s5_glu_a, *s5_glu_b;
  float* out;
  bf16_t *wt_gla_in, *wt_gla_out, *wt_up, *wt_down, *wt_s5_in, *wt_glu;
  float *lam, *bb;
  bf16_t* a1;
  char* big;
  unsigned* bar;
  bf16_t* xr;
  int phase_lo, phase_hi;
};

typedef float f32x2 __attribute__((ext_vector_type(2)));
typedef __bf16 bf16x2_t __attribute__((ext_vector_type(2)));
__device__ __forceinline__ unsigned cvt_pk_bf16(float lo, float hi) {
  const f32x2 v = {lo, hi};
  const bf16x2_t b = __builtin_convertvector(v, bf16x2_t);
  return __builtin_bit_cast(unsigned, b);
}
__device__ __forceinline__ float bf2f(bf16_t v) { return __uint_as_float(((unsigned)v) << 16); }
__device__ __forceinline__ float bflo(unsigned w) { return __uint_as_float(w << 16); }
__device__ __forceinline__ float bfhi(unsigned w) { return __uint_as_float(w & 0xffff0000u); }
__device__ __forceinline__ bf16_t f2bf(float f) { return (bf16_t)(cvt_pk_bf16(f, 0.f) & 0xffffu); }

__device__ __forceinline__ float wave_sum(float v) {
  v += __shfl_xor(v, 32); v += __shfl_xor(v, 16); v += __shfl_xor(v, 8);
  v += __shfl_xor(v, 4);  v += __shfl_xor(v, 2);  v += __shfl_xor(v, 1);
  return v;
}
__device__ __forceinline__ void lds_fence() { asm volatile("s_waitcnt lgkmcnt(0)" ::: "memory"); }

__device__ __forceinline__ void transpose_tiles(const Params& p, char* smem) {
  const int sub = threadIdx.x >> 8, tid = threadIdx.x & 255;
  float* ts = (float*)(smem + sub * 32768);
  for (int base = blockIdx.x * 2; base < 5952; base += gridDim.x * 2) {
    int t = base + sub; const float* src; int ld, K, nvalid; bf16_t* dst; int glu = 0;
    if (t < 832) { src = p.gla_w_in; ld = 3088; K = 1024; nvalid = 3088; dst = p.wt_gla_in; }
    else if ((t -= 832) < 256) { src = p.gla_w_out; ld = 1024; K = 1024; nvalid = 1024; dst = p.wt_gla_out; }
    else if ((t -= 256) < 2048) { int l = t >> 10; t &= 1023; src = p.w_up + (size_t)l * 1024 * 4096; ld = 4096; K = 1024; nvalid = 4096; dst = p.wt_up + (size_t)l * 4096 * 1024; }
    else if ((t -= 2048) < 2048) { int l = t >> 10; t &= 1023; src = p.w_down + (size_t)l * 4096 * 1024; ld = 1024; K = 4096; nvalid = 1024; dst = p.wt_down + (size_t)l * 1024 * 4096; }
    else if ((t -= 2048) < 256) { src = p.s5_w_in; ld = 1024; K = 1024; nvalid = 1024; dst = p.wt_s5_in; }
    else { t -= 256; src = p.s5_glu_a; ld = 1024; K = 1024; nvalid = 2048; dst = p.wt_glu; glu = 1; }
    const int ktiles = K >> 6;
    const int nt = t / ktiles, kt = t - nt * ktiles;
    const int n0 = nt * 64, k0 = kt * 64;
    const int nl = tid & 63, kl = tid >> 6;
    const int n = n0 + nl;
    const float* cp = nullptr;
    if (glu) {
      const int col = (n >> 5) * 16 + (n & 15);
      cp = (((n >> 4) & 1) ? p.s5_glu_b : p.s5_glu_a) + col;
    } else if (n < nvalid) cp = src + n;
    __syncthreads();
float tv[16];
#pragma unroll
    for (int i = 0; i < 16; ++i) tv[i] = cp ? cp[(size_t)(k0 + kl + 4 * i) * ld] : 0.f;
#pragma unroll
    for (int i = 0; i < 16; ++i) ts[(kl + 4 * i) * 65 + nl] = tv[i];
    __syncthreads();
    const int k8 = (tid & 7) * 8;
#pragma unroll
    for (int i = 0; i < 2; ++i) {
      const int nn = (tid >> 3) + 32 * i;
      u32x4 w;
      w.x = cvt_pk_bf16(ts[(k8 + 0) * 65 + nn], ts[(k8 + 1) * 65 + nn]);
      w.y = cvt_pk_bf16(ts[(k8 + 2) * 65 + nn], ts[(k8 + 3) * 65 + nn]);
      w.z = cvt_pk_bf16(ts[(k8 + 4) * 65 + nn], ts[(k8 + 5) * 65 + nn]);
      w.w = cvt_pk_bf16(ts[(k8 + 6) * 65 + nn], ts[(k8 + 7) * 65 + nn]);
      *(u32x4*)(dst + (size_t)(n0 + nn) * K + k0 + k8) = w;
    }
  }
}

__device__ __forceinline__ void s5_consts(const Params& p) {
  for (int i = blockIdx.x * 512 + threadIdx.x; i < 4096; i += gridDim.x * 512) {
    const int g = i >> 6;
    const float ar = p.s5_a_re[i], ai = p.s5_a_im[i];
    const float dt = expf(p.s5_log_step[g]);
    const float mag = expf(ar * dt);
    const float lr = mag * cosf(ai * dt), li = mag * sinf(ai * dt);
    const float nr = lr - 1.0f, ni = li;
    const float den = ar * ar + ai * ai;
    const float zr = (nr * ar + ni * ai) / den;
    const float zi = (ni * ar - nr * ai) / den;
    p.lam[i] = lr; p.lam[4096 + i] = li;
#pragma unroll
    for (int c = 0; c < 16; ++c) {
      const float br = p.s5_b_re[i * 16 + c], bi = p.s5_b_im[i * 16 + c];
      p.bb[i * 16 + c] = zr * br - zi * bi;
      p.bb[65536 + i * 16 + c] = zr * bi + zi * br;
    }
  }
}

__device__ __forceinline__ void norm0_rows(const Params& p) {
  const int lane = threadIdx.x & 63, wid = threadIdx.x >> 6;
  for (int row = blockIdx.x * 8 + wid; row < T; row += gridDim.x * 8) {
    const float* xr = (row < TP) ? p.x_prompt + (size_t)row * 1024 : p.x_sample + (size_t)(row - TP) * 1024;
    f32x4 v[4]; float ss = 0.f;
#pragma unroll
    for (int i = 0; i < 4; ++i) { v[i] = *(const f32x4*)(xr + i * 256 + lane * 4); ss += v[i][0] * v[i][0] + v[i][1] * v[i][1] + v[i][2] * v[i][2] + v[i][3] * v[i][3]; }
    ss = wave_sum(ss);
    const float r = rsqrtf(ss * (1.0f / 1024.0f) + EPS);
#pragma unroll
    for (int i = 0; i < 4; ++i) {
      const f32x4 g = *(const f32x4*)(p.g_pre_mix + i * 256 + lane * 4);
      u32x2 w; w.x = cvt_pk_bf16(v[i][0] * r * g[0], v[i][1] * r * g[1]); w.y = cvt_pk_bf16(v[i][2] * r * g[2], v[i][3] * r * g[3]);
      *(u32x2*)(p.a1 + (size_t)row * 1024 + i * 256 + lane * 4) = w;
      u32x2 xw; xw.x = cvt_pk_bf16(v[i][0], v[i][1]); xw.y = cvt_pk_bf16(v[i][2], v[i][3]);
      *(u32x2*)(p.xr + (size_t)row * 1024 + i * 256 + lane * 4) = xw;
    }
  }
}

__device__ __forceinline__ void rows_update(const Params& p, const bf16_t* msrc, const float* gpost, const float* gnext) {
  const int lane = threadIdx.x & 63, wid = threadIdx.x >> 6;
  const int nwav = gridDim.x * 8;
  f32x4 gp[4], gn[4];
#pragma unroll
  for (int i = 0; i < 4; ++i) {
    gp[i] = *(const f32x4*)(gpost + i * 256 + lane * 4);
    gn[i] = gnext ? *(const f32x4*)(gnext + i * 256 + lane * 4) : (f32x4){0.f, 0.f, 0.f, 0.f};
  }
  for (int row0 = blockIdx.x * 8 + wid; row0 < T; row0 += 2 * nwav) {
    u32x2 mw[2][4], xw[2][4]; bool ok[2];
#pragma unroll
    for (int r = 0; r < 2; ++r) {
      const int row = row0 + r * nwav; ok[r] = row < T;
      if (ok[r]) {
#pragma unroll
        for (int i = 0; i < 4; ++i) { mw[r][i] = *(const u32x2*)(msrc + (size_t)row * 1024 + i * 256 + lane * 4); xw[r][i] = *(const u32x2*)(p.xr + (size_t)row * 1024 + i * 256 + lane * 4); }
      }
    }
#pragma unroll
    for (int r = 0; r < 2; ++r) {
      if (!ok[r]) continue;
      const int row = row0 + r * nwav;
      f32x4 m[4]; float ss = 0.f;
#pragma unroll
      for (int i = 0; i < 4; ++i) {
        m[i][0] = bflo(mw[r][i].x); m[i][1] = bfhi(mw[r][i].x); m[i][2] = bflo(mw[r][i].y); m[i][3] = bfhi(mw[r][i].y);
        ss += m[i][0] * m[i][0] + m[i][1] * m[i][1] + m[i][2] * m[i][2] + m[i][3] * m[i][3];
      }
      ss = wave_sum(ss);
      const float rs = rsqrtf(ss * (1.0f / 1024.0f) + EPS);
      float ss2 = 0.f;
#pragma unroll
      for (int i = 0; i < 4; ++i) {
        const float x0 = bflo(xw[r][i].x), x1 = bfhi(xw[r][i].x), x2 = bflo(xw[r][i].y), x3 = bfhi(xw[r][i].y);
        m[i][0] = x0 + m[i][0] * rs * gp[i][0]; m[i][1] = x1 + m[i][1] * rs * gp[i][1];
        m[i][2] = x2 + m[i][2] * rs * gp[i][2]; m[i][3] = x3 + m[i][3] * rs * gp[i][3];
        ss2 += m[i][0] * m[i][0] + m[i][1] * m[i][1] + m[i][2] * m[i][2] + m[i][3] * m[i][3];
        if (gnext) {
          u32x2 w; w.x = cvt_pk_bf16(m[i][0], m[i][1]); w.y = cvt_pk_bf16(m[i][2], m[i][3]);
          *(u32x2*)(p.xr + (size_t)row * 1024 + i * 256 + lane * 4) = w;
        } else {
          *(f32x4*)(p.out + OFF_Y + (size_t)row * 1024 + i * 256 + lane * 4) = m[i];
        }
      }
      if (gnext) {
        ss2 = wave_sum(ss2);
        const float r2 = rsqrtf(ss2 * (1.0f / 1024.0f) + EPS);
#pragma unroll
        for (int i = 0; i < 4; ++i) {
          u32x2 w; w.x = cvt_pk_bf16(m[i][0] * r2 * gn[i][0], m[i][1] * r2 * gn[i][1]); w.y = cvt_pk_bf16(m[i][2] * r2 * gn[i][2], m[i][3] * r2 * gn[i][3]);
          *(u32x2*)(p.a1 + (size_t)row * 1024 + i * 256 + lane * 4) = w;
        }
      }
    }
  }
}

constexpr int G_BM = 256, G_BK = 64, G_HALF = 128, G_HTB = G_HALF * G_BK * 2;
__device__ __forceinline__ int g_lds_byte(int r, int c) { const int st = (r >> 4) * 2 + (c >> 5), rr = r & 15, cc = c & 31, ob = rr * 64 + cc * 2; return st * 1024 + (ob ^ (((ob >> 9) & 1) << 5)); }
__device__ __forceinline__ void g_stage_rc(int b, int& R, int& C) { const int st = b / 1024, sb = b % 1024, swz = sb ^ (((sb >> 9) & 1) << 5); R = (st >> 1) * 16 + swz / 64; C = (st & 1) * 32 + (swz % 64) / 2; }
struct Unit { int pm, pn; };
__device__ __forceinline__ bool g_next(int i, int nM, int nN, int nwg, int G, int c, Unit& u) {
  const long L = (long)i * G + c; if (L >= nwg) return false;
  int wgid = (int)L; { const int q = nwg / 8, r = nwg % 8, xcd = wgid % 8, off = wgid / 8; wgid = (xcd < r ? xcd * (q + 1) : r * (q + 1) + (xcd - r) * q) + off; }
  const int nig = 8 * nN, gid = wgid / nig, fm = gid * 8, gsz = (nM - fm) < 8 ? (nM - fm) : 8;
  u.pm = fm + ((wgid % nig) % gsz); u.pn = (wgid % nig) / gsz; return true;
}

template <int EPI>
__device__ __forceinline__ void gemm_epilogue(const f32x4 (&acc)[2][2][4][2], const Unit& u, int wr, int wc, int fr, int fq, void* outp, int ldo) {
  const int row0 = u.pm * G_BM + wr * 64 + fr;
#pragma unroll
  for (int ai = 0; ai < 2; ++ai)
#pragma unroll
    for (int m = 0; m < 4; ++m) {
      const size_t row = (size_t)(row0 + ai * G_HALF + m * 16);
#pragma unroll
      for (int bj = 0; bj < 2; ++bj) {
        if (EPI == 3) {
          const int col = u.pn * 128 + bj * 64 + wc * 16 + 4 * fq;
          const f32x4 a = acc[ai][bj][m][0], b = acc[ai][bj][m][1]; f32x4 o;
#pragma unroll
          for (int j = 0; j < 4; ++j) o[j] = a[j] / (1.0f + __expf(-b[j]));
          u32x2 w; w.x = cvt_pk_bf16(o[0], o[1]); w.y = cvt_pk_bf16(o[2], o[3]);
          *(u32x2*)((bf16_t*)outp + row * ldo + col) = w;
        } else if (EPI == 2) {
#pragma unroll
          for (int n = 0; n < 2; ++n) {
            const int col = u.pn * G_BM + wc * 32 + 4 * fq + bj * G_HALF + n * 16;
            *(f32x4*)((float*)outp + row * ldo + col) = acc[ai][bj][m][n];
          }
        } else {
          const int col = u.pn * G_BM + wc * 32 + 8 * fq + bj * G_HALF;
          f32x4 v0 = acc[ai][bj][m][0], v1 = acc[ai][bj][m][1];
          if (EPI == 1) {
#pragma unroll
            for (int j = 0; j < 4; ++j) { const float t0 = fmaxf(v0[j], 0.f), t1 = fmaxf(v1[j], 0.f); v0[j] = t0 * t0; v1[j] = t1 * t1; }
          }
          u32x4 w; w.x = cvt_pk_bf16(v0[0], v0[1]); w.y = cvt_pk_bf16(v0[2], v0[3]); w.z = cvt_pk_bf16(v1[0], v1[1]); w.w = cvt_pk_bf16(v1[2], v1[3]);
          *(u32x4*)((bf16_t*)outp + row * ldo + col) = w;
        }
      }
    }
}

template <int EPI>
__device__ __forceinline__ void gemm_phase(LAS unsigned char* lds, const bf16_t* gA, const bf16_t* gBt, const int M, const int N, const int K, void* outp, const int ldo) {
  const int tid = threadIdx.x, wid = __builtin_amdgcn_readfirstlane(tid >> 6), lane = tid & 63, wr = wid >> 2, wc = wid & 3, fr = lane & 15, fq = lane >> 4;
  const int nt = K / G_BK;
  const int nM = M / G_BM, nN = N / G_BM, nwg = nM * nN, G = (int)gridDim.x, c = (int)blockIdx.x;
  constexpr bool PERM = (EPI == 0 || EPI == 1);
  unsigned voffA[2], voffB[2];
#pragma unroll
  for (int i = 0; i < 2; ++i) { int R, C; g_stage_rc(tid * 16 + i * 8192, R, C);
    int Rb = R; if (PERM) { const int rho = R & 31, nn = rho >> 4, ii = rho & 15; Rb = (R & ~31) + 8 * (ii >> 2) + 4 * nn + (ii & 3); }
    voffA[i] = (unsigned)(R * K + C) * 2u; voffB[i] = (unsigned)(Rb * K + C) * 2u; }
  const size_t kstep = (size_t)(G_BK * 2);
  const size_t hstep = (size_t)G_HALF * K * 2;
  const size_t tstep = 2 * hstep;
  const unsigned ldsw = (unsigned)wid * 1024u;
  const int aoff = g_lds_byte(wr * 64 + fr, fq * 8), boff = g_lds_byte(wc * 32 + fr, fq * 8);
#define PG8_SA(b, h) (((b) * 2 + (h)) * G_HTB)
#define PG8_SB(b, h) ((4 + (b) * 2 + (h)) * G_HTB)
#define PG8_STAGEX(bufoff, gbase, voff) do { _Pragma("unroll") for (int _i = 0; _i < 2; ++_i) \
    __builtin_amdgcn_global_load_lds((const unsigned*)((const char*)(gbase) + (voff)[_i]), (LAS unsigned*)(lds + (bufoff) + ldsw + _i * 8192), 16, 0, 0); } while (0)
#define PG8_LDA(dst, b, h) do { _Pragma("unroll") for (int m = 0; m < 4; ++m) _Pragma("unroll") for (int k = 0; k < 2; ++k) dst[m][k] = *(const LAS bf16x8*)(lds + PG8_SA(b, h) + aoff + m * 2048 + k * 1024); } while (0)
#define PG8_LDB(dst, b, h) do { _Pragma("unroll") for (int n = 0; n < 2; ++n) _Pragma("unroll") for (int k = 0; k < 2; ++k) dst[n][k] = *(const LAS bf16x8*)(lds + PG8_SB(b, h) + boff + n * 2048 + k * 1024); } while (0)
#define PG8_MMA(ai, bj, At, Bt) do { __builtin_amdgcn_s_setprio(1); _Pragma("unroll") for (int m = 0; m < 4; ++m) _Pragma("unroll") for (int n = 0; n < 2; ++n) _Pragma("unroll") for (int k = 0; k < 2; ++k) \
    acc[ai][bj][m][n] = __builtin_amdgcn_mfma_f32_16x16x32_bf16(Bt[n][k], At[m][k], acc[ai][bj][m][n], 0, 0, 0); __builtin_amdgcn_s_setprio(0); } while (0)
#define PG8_WAIT_V(n) asm volatile("s_waitcnt vmcnt(" #n ")" ::: "memory")
#define PG8_WAIT_L(n) asm volatile("s_waitcnt lgkmcnt(" #n ")" ::: "memory")
#define PG8_BAR __builtin_amdgcn_s_barrier()
#define PG8_SCHED __builtin_amdgcn_sched_barrier(0)
  Unit cur, nxt; int ui = 0;
  if (!g_next(0, nM, nN, nwg, G, c, cur)) return;
  f32x4 acc[2][2][4][2];
#pragma unroll
  for (int a = 0; a < 2; ++a)
#pragma unroll
    for (int b = 0; b < 2; ++b)
#pragma unroll
      for (int m = 0; m < 4; ++m)
#pragma unroll
        for (int n = 0; n < 2; ++n) acc[a][b][m][n] = (f32x4){0.f, 0.f, 0.f, 0.f};
  bf16x8 At[4][2], B0[2][2], B1[2][2];
  const char* cA = (const char*)gA + (size_t)cur.pm * tstep; const char* cB = (const char*)gBt + (size_t)cur.pn * tstep;
  PG8_STAGEX(PG8_SB(0, 0), cB, voffB); PG8_STAGEX(PG8_SA(0, 0), cA, voffA); PG8_STAGEX(PG8_SB(0, 1), cB + hstep, voffB); PG8_STAGEX(PG8_SA(0, 1), cA + hstep, voffA);
  if (wr == 1) PG8_BAR;
  PG8_WAIT_V(4); PG8_BAR;
  PG8_STAGEX(PG8_SB(1, 0), cB + kstep, voffB); PG8_STAGEX(PG8_SA(1, 0), cA + kstep, voffA); PG8_STAGEX(PG8_SB(1, 1), cB + hstep + kstep, voffB);
  PG8_WAIT_V(6); PG8_BAR;
  for (;;) {
    const bool has_next = g_next(ui + 1, nM, nN, nwg, G, c, nxt);
    const char* nA = has_next ? (const char*)gA + (size_t)nxt.pm * tstep : cA; const char* nB = has_next ? (const char*)gBt + (size_t)nxt.pn * tstep : cB;
    for (int t = 0; t < nt; t += 2) {
      const bool last = (t == nt - 2);
      const char* a1 = cA + (size_t)(t + 1) * kstep;
      const char* a2 = last ? nA : cA + (size_t)(t + 2) * kstep; const char* b2 = last ? nB : cB + (size_t)(t + 2) * kstep;
      const char* a3 = a2 + kstep; const char* b3 = b2 + kstep;
      PG8_LDB(B0, 0, 0); PG8_SCHED; PG8_LDA(At, 0, 0); PG8_STAGEX(PG8_SA(1, 1), a1 + hstep, voffA);
      PG8_WAIT_L(8); PG8_BAR; PG8_WAIT_L(0); PG8_MMA(0, 0, At, B0); PG8_BAR; PG8_SCHED;
      PG8_LDB(B1, 0, 1); PG8_STAGEX(PG8_SB(0, 0), b2, voffB);
      PG8_BAR; PG8_WAIT_L(0); PG8_MMA(0, 1, At, B1); PG8_BAR;
      PG8_LDA(At, 0, 1); PG8_STAGEX(PG8_SA(0, 0), a2, voffA);
      PG8_BAR; PG8_WAIT_L(0); PG8_MMA(1, 0, At, B0); PG8_BAR; PG8_SCHED;
      PG8_STAGEX(PG8_SB(0, 1), b2 + hstep, voffB);
      PG8_WAIT_V(6); PG8_BAR; PG8_MMA(1, 1, At, B1); PG8_BAR;
      PG8_LDB(B0, 1, 0); PG8_SCHED; PG8_LDA(At, 1, 0); PG8_STAGEX(PG8_SA(0, 1), a2 + hstep, voffA);
      PG8_WAIT_L(8); PG8_BAR; PG8_WAIT_L(0); PG8_MMA(0, 0, At, B0); PG8_BAR; PG8_SCHED;
      PG8_LDB(B1, 1, 1); PG8_STAGEX(PG8_SB(1, 0), b3, voffB);
      PG8_BAR; PG8_WAIT_L(0); PG8_MMA(0, 1, At, B1); PG8_BAR;
      PG8_LDA(At, 1, 1); PG8_STAGEX(PG8_SA(1, 0), a3, voffA);
      PG8_BAR; PG8_WAIT_L(0); PG8_MMA(1, 0, At, B0); PG8_BAR; PG8_SCHED;
      PG8_STAGEX(PG8_SB(1, 1), b3 + hstep, voffB);
      PG8_WAIT_V(6); PG8_BAR; PG8_MMA(1, 1, At, B1); PG8_BAR;
    }
    gemm_epilogue<EPI>(acc, cur, wr, wc, fr, fq, outp, ldo);
    if (!has_next) break;
#pragma unroll
    for (int a = 0; a < 2; ++a)
#pragma unroll
      for (int b = 0; b < 2; ++b)
#pragma unroll
        for (int m = 0; m < 4; ++m)
#pragma unroll
          for (int n = 0; n < 2; ++n) acc[a][b][m][n] = (f32x4){0.f, 0.f, 0.f, 0.f};
    cur = nxt; cA = nA; cB = nB; ++ui;
  }
  PG8_WAIT_V(0);
  if (wr == 0) PG8_BAR;
  PG8_BAR;
#undef PG8_SA
#undef PG8_SB
#undef PG8_STAGEX
#undef PG8_LDA
#undef PG8_LDB
#undef PG8_MMA
#undef PG8_WAIT_V
#undef PG8_WAIT_L
#undef PG8_BAR
#undef PG8_SCHED
}

template <int EPI, int K, int NF = 2>
__device__ __forceinline__ void sgemm_sample(const bf16_t* __restrict__ A, const bf16_t* __restrict__ Bt, const int N, void* outp, const int ldo, char* smem, const int blk0 = 0) {
  const int tid = threadIdx.x, lane = tid & 63, w = tid >> 6, fr = lane & 15, fq = lane >> 4;
  constexpr int TW = 16 * NF;
  float* red = (float*)smem;
  const int nitems = 8 * (N / TW);
  constexpr int KW = K / 8;
  constexpr int KB = (NF == 2) ? 128 : 64;
  const int nblk = (int)gridDim.x - blk0;
  for (int it = (int)blockIdx.x - blk0; it >= 0 && it < nitems; it += nblk) {
    const int mi = it & 7, ni = it >> 3;
    const bf16_t* Ab = A + (size_t)(TP + mi * 64 + fr) * K + w * KW + fq * 8;
    const bf16_t* Bb = Bt + (size_t)(ni * TW + fr) * K + w * KW + fq * 8;
    f32x4 acc[4][NF];
#pragma unroll
    for (int i = 0; i < 4; ++i)
#pragma unroll
      for (int j = 0; j < NF; ++j) acc[i][j] = (f32x4){0.f, 0.f, 0.f, 0.f};
#pragma unroll 1
    for (int kb = 0; kb < KW; kb += KB) {
      bf16x8 af[KB / 32][4], bfv[KB / 32][NF];
#pragma unroll
      for (int ks = 0; ks < KB / 32; ++ks) {
#pragma unroll
        for (int mf = 0; mf < 4; ++mf) af[ks][mf] = *(const bf16x8*)(Ab + (size_t)(mf * 16) * K + kb + ks * 32);
#pragma unroll
        for (int nf = 0; nf < NF; ++nf) bfv[ks][nf] = *(const bf16x8*)(Bb + (size_t)(nf * 16) * K + kb + ks * 32);
      }
#pragma unroll
      for (int ks = 0; ks < KB / 32; ++ks)
#pragma unroll
        for (int mf = 0; mf < 4; ++mf)
#pragma unroll
          for (int nf = 0; nf < NF; ++nf)
            acc[mf][nf] = __builtin_amdgcn_mfma_f32_16x16x32_bf16(bfv[ks][nf], af[ks][mf], acc[mf][nf], 0, 0, 0);
    }
    __syncthreads();
#pragma unroll
    for (int mf = 0; mf < 4; ++mf)
#pragma unroll
      for (int nf = 0; nf < NF; ++nf)
        *(f32x4*)(red + ((w * 64 + mf * 16 + fr) * TW + nf * 16 + fq * 4)) = acc[mf][nf];
    __syncthreads();
    if (EPI == 3) {
      constexpr int GPT = TW / 32;
      for (int e = tid; e < 64 * GPT * 4; e += 512) {
        const int row = e / (GPT * 4), gq = e % (GPT * 4), gi = gq >> 2, c4 = (gq & 3) * 4;
        f32x4 a = {0.f, 0.f, 0.f, 0.f}, b = {0.f, 0.f, 0.f, 0.f};
#pragma unroll
        for (int ww = 0; ww < 8; ++ww) { a += *(const f32x4*)(red + ((ww * 64 + row) * TW + gi * 32 + c4)); b += *(const f32x4*)(red + ((ww * 64 + row) * TW + gi * 32 + 16 + c4)); }
        f32x4 o;
#pragma unroll
        for (int j = 0; j < 4; ++j) o[j] = a[j] / (1.0f + __expf(-b[j]));
        u32x2 pk; pk.x = cvt_pk_bf16(o[0], o[1]); pk.y = cvt_pk_bf16(o[2], o[3]);
        *(u32x2*)((bf16_t*)outp + (size_t)(TP + mi * 64 + row) * ldo + (ni * GPT + gi) * 16 + c4) = pk;
      }
    } else {
      for (int e = tid; e < 64 * (TW / 4); e += 512) {
        const int row = e / (TW / 4), c4 = (e % (TW / 4)) * 4;
        f32x4 v = {0.f, 0.f, 0.f, 0.f};
#pragma unroll
        for (int ww = 0; ww < 8; ++ww) v += *(const f32x4*)(red + ((ww * 64 + row) * TW + c4));
        const size_t o = (size_t)(TP + mi * 64 + row) * ldo + ni * TW + c4;
        if (EPI == 2) {
          *(f32x4*)((float*)outp + o) = v;
        } else {
          if (EPI == 1) {
#pragma unroll
            for (int j = 0; j < 4; ++j) { const float t = fmaxf(v[j], 0.f); v[j] = t * t; }
          }
          u32x2 pk; pk.x = cvt_pk_bf16(v[0], v[1]); pk.y = cvt_pk_bf16(v[2], v[3]);
          *(u32x2*)((bf16_t*)outp + o) = pk;
        }
      }
    }
  }
  __syncthreads();
}

__device__ __forceinline__ float gate_decay(float z) {
  const float ls = fminf(z, 0.f) - log1pf(expf(-fabsf(z)));
  return expf(ls * 0.0625f);
}

__device__ __forceinline__ void gla_sample_item(const Params& p, const int item, char* smem, const int tid) {
  const int h = item & 3, b = item >> 2;
  float* wg = (float*)smem;
  float* bg = wg + 2048;
  float* gl_s = bg + 128;
  float* q_s = gl_s + 64;
  float* k_s = q_s + 512;
  float* e_s = k_s + 512;
  const bf16_t* proj = (const bf16_t*)p.big;
  const int tok0 = TP + b * 4;
  __syncthreads();
  for (int i = tid; i < 2048; i += 256) { const int r = i >> 7, k = i & 127; wg[i] = p.gla_w_gate_up[r * 512 + h * 128 + k]; }
  if (tid < 128) bg[tid] = p.gla_b_gate[h * 128 + tid];
  if (tid < 64) gl_s[tid] = bf2f(proj[(size_t)(tok0 + (tid >> 4)) * PS + 3072 + (tid & 15)]);
  for (int i = tid; i < 512; i += 256) {
    const int tt = i >> 7, k = i & 127;
    q_s[i] = bf2f(proj[(size_t)(tok0 + tt) * PS + h * 128 + k]) * 0.08838834764831845f;
    k_s[i] = bf2f(proj[(size_t)(tok0 + tt) * PS + 512 + h * 128 + k]);
  }
  float vr[4];
#pragma unroll
  for (int tt = 0; tt < 4; ++tt) vr[tt] = bf2f(proj[(size_t)(tok0 + tt) * PS + 1024 + h * 256 + tid]);
  __syncthreads();
  for (int i = tid; i < 512; i += 256) {
    const int tt = i >> 7, k = i & 127;
    float z = bg[k];
#pragma unroll
    for (int r = 0; r < 16; ++r) z += gl_s[tt * 16 + r] * wg[r * 128 + k];
    e_s[i] = gate_decay(z);
  }
  __syncthreads();
  const float* sin_ = p.state_gla + ((size_t)(b * 4 + h) * 128) * 256 + tid;
  float* sout = p.out + OFF_GLA_S + ((size_t)(b * 4 + h) * 128) * 256 + tid;
  float o[4] = {0.f, 0.f, 0.f, 0.f};
  for (int kb = 0; kb < 128; kb += 16) {
    float Sv[16];
#pragma unroll
    for (int i = 0; i < 16; ++i) Sv[i] = sin_[(size_t)(kb + i) * 256];
#pragma unroll
    for (int i = 0; i < 16; ++i) {
      const int k = kb + i;
#pragma unroll
      for (int tt = 0; tt < 4; ++tt) { Sv[i] = e_s[tt * 128 + k] * Sv[i] + k_s[tt * 128 + k] * vr[tt]; o[tt] += q_s[tt * 128 + k] * Sv[i]; }
    }
#pragma unroll
    for (int i = 0; i < 16; ++i) sout[(size_t)(kb + i) * 256] = Sv[i];
  }
#pragma unroll
  for (int tt = 0; tt < 4; ++tt) p.a1[(size_t)(tok0 + tt) * 1024 + h * 256 + tid] = f2bf(o[tt]);
}


constexpr size_t KT_OFF = (size_t)T * PS * 2;
constexpr size_t VEC_OFF = KT_OFF + (size_t)16777216;

__device__ __forceinline__ void gla_prep(const Params& p, char* smem) {
  float* gl_s = (float*)smem;
  const int c = threadIdx.x;
  bf16_t* proj = (bf16_t*)p.big;
  bf16_t* KT = (bf16_t*)(p.big + KT_OFF);
  float* VEC = (float*)(p.big + VEC_OFF);
  float wg[16];
#pragma unroll
  for (int r = 0; r < 16; ++r) wg[r] = p.gla_w_gate_up[r * 512 + c];
  const float bias = p.gla_b_gate[c];
  for (int item = blockIdx.x; item < 256; item += gridDim.x) {
    const int tok0 = (item >> 5) * 2048 + (item & 31) * 64;
    __syncthreads();
    for (int i = threadIdx.x; i < 1024; i += 512) gl_s[i] = bf2f(proj[(size_t)(tok0 + (i >> 4)) * PS + 3072 + (i & 15)]);
    __syncthreads();
    float bc[64]; float run = 0.f;
#pragma unroll
    for (int t = 0; t < 64; ++t) {
      float z = bias;
#pragma unroll
      for (int r = 0; r < 16; ++r) z += gl_s[t * 16 + r] * wg[r];
      const float ls = fminf(z, 0.f) - __logf(1.0f + __expf(-fabsf(z)));
      run += ls * 0.0625f; bc[t] = run;
    }
    const float bref = bc[32], blast = bc[63];
    bf16_t* qp = proj + (size_t)tok0 * PS + c;
    bf16_t* kp = qp + 512;
    bf16_t* ktp = KT + ((size_t)(item * 4 + (c >> 7)) * 128 + (c & 127)) * 64;
#pragma unroll
    for (int t8 = 0; t8 < 8; ++t8) {
      float kk[8];
#pragma unroll
      for (int i = 0; i < 8; ++i) {
        const int t = t8 * 8 + i;
        const float q = bf2f(qp[(size_t)t * PS]), k = bf2f(kp[(size_t)t * PS]);
        const float qi = q * 0.08838834764831845f * __expf(bc[t] - bref);
        kk[i] = k * __expf(bref - bc[t]);
        qp[(size_t)t * PS] = f2bf(qi);
        kp[(size_t)t * PS] = f2bf(kk[i]);
      }
      u32x4 w; w.x = cvt_pk_bf16(kk[0], kk[1]); w.y = cvt_pk_bf16(kk[2], kk[3]); w.z = cvt_pk_bf16(kk[4], kk[5]); w.w = cvt_pk_bf16(kk[6], kk[7]);
      *(u32x4*)(ktp + t8 * 8) = w;
    }
    VEC[(size_t)(item * 3 + 0) * 512 + c] = __expf(bref);
    VEC[(size_t)(item * 3 + 1) * 512 + c] = __expf(blast - bref);
    VEC[(size_t)(item * 3 + 2) * 512 + c] = __expf(blast);
  }
}

__device__ __forceinline__ bf16x8 lfrag(const char* base, int row, int rowbytes, int chunk, int mask) {
  return *(const bf16x8*)(base + row * rowbytes + ((chunk ^ (row & mask)) << 4));
}

struct GlaRegs { u32x4 q[2], k[2], t[2], v; float c; };

__device__ __forceinline__ void gla_main_item(const Params& p, const int item, char* smem) {
  const int b = item >> 4, h = (item >> 2) & 3, v0 = (item & 3) * 64;
  const int tid = threadIdx.x, lane = tid & 63, w = tid >> 6, fr = lane & 15, fq = lane >> 4;
  char* Qs = smem;
  char* Ks = smem + 16384;
  char* KTs = smem + 32768;
  char* VTs = smem + 49152;
  char* ATs = smem + 57344;
  char* HTs = smem + 65536;
  float* VCs = (float*)(smem + 81920);
  const bf16_t* proj = (const bf16_t*)p.big;
  const bf16_t* KT = (const bf16_t*)(p.big + KT_OFF);
  const float* VEC = (const float*)(p.big + VEC_OFF);
  f32x4 hacc[4];
#pragma unroll
  for (int i = 0; i < 4; ++i) hacc[i] = (f32x4){0.f, 0.f, 0.f, 0.f};
  const int qrow0 = tid >> 4, qch = tid & 15;
  const int trow0 = tid >> 3, tch = tid & 7;
  const int vt_t = tid >> 3, vt_v = (tid & 7) * 8;
  auto load_regs = [&](const int n, GlaRegs& R) {
    const int tok0 = b * 2048 + n * 64, ci = b * 32 + n;
#pragma unroll
    for (int i = 0; i < 2; ++i) {
      const bf16_t* r = proj + (size_t)(tok0 + qrow0 + 32 * i) * PS + h * 128 + qch * 8;
      R.q[i] = *(const u32x4*)r; R.k[i] = *(const u32x4*)(r + 512);
      R.t[i] = *(const u32x4*)(KT + ((size_t)(ci * 4 + h) * 128 + trow0 + 64 * i) * 64 + tch * 8);
    }
    R.v = *(const u32x4*)(proj + (size_t)(tok0 + vt_t) * PS + 1024 + h * 256 + v0 + vt_v);
    R.c = (tid < 384) ? VEC[(size_t)(ci * 3 + (tid >> 7)) * 512 + h * 128 + (tid & 127)] : 0.f;
  };
  auto store_regs = [&](const GlaRegs& R) {
#pragma unroll
    for (int i = 0; i < 2; ++i) {
      const int r = qrow0 + 32 * i;
      *(u32x4*)(Qs + r * 256 + ((qch ^ (r & 15)) << 4)) = R.q[i]; *(u32x4*)(Ks + r * 256 + ((qch ^ (r & 15)) << 4)) = R.k[i];
      const int k = trow0 + 64 * i; *(u32x4*)(KTs + k * 128 + ((tch ^ (k & 7)) << 4)) = R.t[i];
    }
    const unsigned wv[4] = {R.v.x, R.v.y, R.v.z, R.v.w};
#pragma unroll
    for (int i = 0; i < 8; ++i) {
      const int v = vt_v + i;
      *(bf16_t*)(VTs + v * 128 + (((vt_t >> 3) ^ (v & 7)) << 4) + (vt_t & 7) * 2) = (bf16_t)((wv[i >> 1] >> ((i & 1) * 16)) & 0xffffu);
    }
    if (tid < 384) VCs[tid] = R.c;
  };
  auto body = [&](const int n) {
    const int tok0 = b * 2048 + n * 64;
    {
      const int k = w * 16 + fq * 4;
      const f32x4 er = *(const f32x4*)(VCs + k);
#pragma unroll
      for (int vt = 0; vt < 4; ++vt) {
        const int v = vt * 16 + fr;
        u32x2 pk; pk.x = cvt_pk_bf16(hacc[vt][0] * er[0], hacc[vt][1] * er[1]); pk.y = cvt_pk_bf16(hacc[vt][2] * er[2], hacc[vt][3] * er[3]);
        *(u32x2*)(HTs + v * 256 + (((k >> 3) ^ (v & 15)) << 4) + (k & 7) * 2) = pk;
      }
    }
    {
      const int tt = w >> 1, st0 = (w & 1) * 2;
      f32x4 d[2] = {(f32x4){0.f, 0.f, 0.f, 0.f}, (f32x4){0.f, 0.f, 0.f, 0.f}};
#pragma unroll
      for (int ks = 0; ks < 4; ++ks) {
        const bf16x8 qf = lfrag(Qs, tt * 16 + fr, 256, ks * 4 + fq, 15);
#pragma unroll
        for (int s2 = 0; s2 < 2; ++s2) {
          const bf16x8 kf = lfrag(Ks, (st0 + s2) * 16 + fr, 256, ks * 4 + fq, 15);
          d[s2] = __builtin_amdgcn_mfma_f32_16x16x32_bf16(kf, qf, d[s2], 0, 0, 0);
        }
      }
      const int t = tt * 16 + fr;
#pragma unroll
      for (int s2 = 0; s2 < 2; ++s2) {
        const int s = (st0 + s2) * 16 + fq * 4;
        const float a0 = (s + 0 <= t) ? d[s2][0] : 0.f, a1 = (s + 1 <= t) ? d[s2][1] : 0.f, a2 = (s + 2 <= t) ? d[s2][2] : 0.f, a3 = (s + 3 <= t) ? d[s2][3] : 0.f;
        u32x2 pk; pk.x = cvt_pk_bf16(a0, a1); pk.y = cvt_pk_bf16(a2, a3);
        *(u32x2*)(ATs + t * 128 + (((s >> 3) ^ (t & 7)) << 4) + (s & 7) * 2) = pk;
      }
    }
    __syncthreads();
    {
      const int tt = w >> 1, vt0 = (w & 1) * 2;
      f32x4 o[2] = {(f32x4){0.f, 0.f, 0.f, 0.f}, (f32x4){0.f, 0.f, 0.f, 0.f}};
#pragma unroll
      for (int ks = 0; ks < 2; ++ks) {
        const bf16x8 af = lfrag(ATs, tt * 16 + fr, 128, ks * 4 + fq, 7);
#pragma unroll
        for (int v2 = 0; v2 < 2; ++v2) o[v2] = __builtin_amdgcn_mfma_f32_16x16x32_bf16(lfrag(VTs, (vt0 + v2) * 16 + fr, 128, ks * 4 + fq, 7), af, o[v2], 0, 0, 0);
      }
#pragma unroll
      for (int ks = 0; ks < 4; ++ks) {
        const bf16x8 qf = lfrag(Qs, tt * 16 + fr, 256, ks * 4 + fq, 15);
#pragma unroll
        for (int v2 = 0; v2 < 2; ++v2) o[v2] = __builtin_amdgcn_mfma_f32_16x16x32_bf16(lfrag(HTs, (vt0 + v2) * 16 + fr, 256, ks * 4 + fq, 15), qf, o[v2], 0, 0, 0);
      }
#pragma unroll
      for (int v2 = 0; v2 < 2; ++v2) {
        u32x2 pk; pk.x = cvt_pk_bf16(o[v2][0], o[v2][1]); pk.y = cvt_pk_bf16(o[v2][2], o[v2][3]);
        *(u32x2*)(p.a1 + (size_t)(tok0 + tt * 16 + fr) * 1024 + h * 256 + v0 + (vt0 + v2) * 16 + fq * 4) = pk;
      }
    }
    {
      const int k = w * 16 + fq * 4;
      const f32x4 ec = *(const f32x4*)(VCs + 128 + k), dc = *(const f32x4*)(VCs + 256 + k);
      f32x4 u[4];
#pragma unroll
      for (int vt = 0; vt < 4; ++vt) u[vt] = (f32x4){0.f, 0.f, 0.f, 0.f};
#pragma unroll
      for (int ks = 0; ks < 2; ++ks) {
        const bf16x8 kf = lfrag(KTs, w * 16 + fr, 128, ks * 4 + fq, 7);
#pragma unroll
        for (int vt = 0; vt < 4; ++vt) u[vt] = __builtin_amdgcn_mfma_f32_16x16x32_bf16(kf, lfrag(VTs, vt * 16 + fr, 128, ks * 4 + fq, 7), u[vt], 0, 0, 0);
      }
#pragma unroll
      for (int vt = 0; vt < 4; ++vt)
#pragma unroll
        for (int j = 0; j < 4; ++j) hacc[vt][j] = dc[j] * hacc[vt][j] + ec[j] * u[vt][j];
    }
  };
  GlaRegs RA, RB;
  __syncthreads();
  load_regs(0, RA);
  store_regs(RA);
  __syncthreads();
  load_regs(1, RA);
  for (int n = 0; n < 32; n += 2) {
    if (n + 2 < 32) load_regs(n + 2, RB);
    body(n);
    __syncthreads();
    store_regs(RA);
    __syncthreads();
    if (n + 3 < 32) load_regs(n + 3, RA);
    body(n + 1);
    __syncthreads();
    if (n + 2 < 32) store_regs(RB);
    __syncthreads();
  }
  float* st = p.out + OFF_GLA_P + ((size_t)(b * 4 + h) * 128) * 256;
#pragma unroll
  for (int vt = 0; vt < 4; ++vt)
#pragma unroll
    for (int j = 0; j < 4; ++j) st[(size_t)(w * 16 + fq * 4 + j) * 256 + v0 + vt * 16 + fr] = hacc[vt][j];
}

__device__ __forceinline__ void gla_phase(const Params& p, char* smem) {
  const int sub = threadIdx.x >> 8, tid = threadIdx.x & 255;
  const int G = (int)gridDim.x;
  if (G >= 256) {
    if ((int)blockIdx.x < 128) gla_main_item(p, blockIdx.x, smem);
    else for (int base = ((int)blockIdx.x - 128) * 2; base < 512; base += (G - 128) * 2) gla_sample_item(p, base + sub, smem + sub * 65536, tid);
  } else {
    for (int item = blockIdx.x; item < 128; item += G) gla_main_item(p, item, smem);
    for (int base = blockIdx.x * 2; base < 512; base += G * 2) gla_sample_item(p, base + sub, smem + sub * 65536, tid);
  }
}

__device__ __forceinline__ void gla_gate_rows(const Params& p) {
  const int lane = threadIdx.x & 63, wid = threadIdx.x >> 6;
  const bf16_t* proj = (const bf16_t*)p.big;
  const int nwav = gridDim.x * 8;
  f32x4 g[4];
#pragma unroll
  for (int i = 0; i < 4; ++i) g[i] = *(const f32x4*)(p.gla_g_head + i * 256 + lane * 4);
  for (int row0 = blockIdx.x * 8 + wid; row0 < T; row0 += 2 * nwav) {
    u32x2 ow[2][4], rw[2][4]; bool ok[2];
#pragma unroll
    for (int r = 0; r < 2; ++r) {
      const int row = row0 + r * nwav; ok[r] = row < T;
      if (ok[r]) {
#pragma unroll
        for (int i = 0; i < 4; ++i) { ow[r][i] = *(const u32x2*)(p.a1 + (size_t)row * 1024 + i * 256 + lane * 4); rw[r][i] = *(const u32x2*)(proj + (size_t)row * PS + 2048 + i * 256 + lane * 4); }
      }
    }
#pragma unroll
    for (int r = 0; r < 2; ++r) {
      if (!ok[r]) continue;
      const int row = row0 + r * nwav;
#pragma unroll
      for (int i = 0; i < 4; ++i) {
        const float o[4] = {bflo(ow[r][i].x), bfhi(ow[r][i].x), bflo(ow[r][i].y), bfhi(ow[r][i].y)};
        float ss = o[0] * o[0] + o[1] * o[1] + o[2] * o[2] + o[3] * o[3];
        ss = wave_sum(ss);
        const float rs = rsqrtf(ss * (1.0f / 256.0f) + EPS);
        const float rr[4] = {bflo(rw[r][i].x), bfhi(rw[r][i].x), bflo(rw[r][i].y), bfhi(rw[r][i].y)};
        float y[4];
#pragma unroll
        for (int j = 0; j < 4; ++j) y[j] = o[j] * rs * g[i][j] * (rr[j] / (1.0f + __expf(-rr[j])));
        u32x2 w; w.x = cvt_pk_bf16(y[0], y[1]); w.y = cvt_pk_bf16(y[2], y[3]);
        *(u32x2*)(p.a1 + (size_t)row * 1024 + i * 256 + lane * 4) = w;
      }
    }
  }
}

__device__ __forceinline__ bf16x8 pack8(const float* s, float sgn) {
  const f32x4 a = *(const f32x4*)s, b = *(const f32x4*)(s + 4);
  union { u32x4 u; bf16x8 v; } r;
  r.u.x = cvt_pk_bf16(a[0] * sgn, a[1] * sgn); r.u.y = cvt_pk_bf16(a[2] * sgn, a[3] * sgn);
  r.u.z = cvt_pk_bf16(b[0] * sgn, b[1] * sgn); r.u.w = cvt_pk_bf16(b[2] * sgn, b[3] * sgn);
  return r.v;
}

struct S5Consts { bf16x8 Bb[8]; bf16x8 Cc[4]; float lr, li, dsk; };

__device__ __forceinline__ void s5_load_consts(const Params& p, const int g, const int lane, S5Consts& k) {
  const int fr = lane & 15, fq = lane >> 4;
  const bf16x8 zero8 = {0, 0, 0, 0, 0, 0, 0, 0};
#pragma unroll
  for (int nt = 0; nt < 8; ++nt) {
    const int pp = nt * 8 + (fr >> 1);
    const float* src = p.bb + ((fr & 1) ? 65536 : 0) + (size_t)(g * 64 + pp) * 16 + (fq & 1) * 8;
    const bf16x8 v = pack8(src, 1.0f);
    k.Bb[nt] = (fq < 2) ? v : zero8;
  }
#pragma unroll
  for (int ks = 0; ks < 4; ++ks) {
    const int p0 = ks * 16 + fq * 4;
    const f32x4 cr = *(const f32x4*)(p.s5_c_re + (size_t)(g * 16 + fr) * 64 + p0), ci = *(const f32x4*)(p.s5_c_im + (size_t)(g * 16 + fr) * 64 + p0);
    union { u32x4 u; bf16x8 v; } r;
    r.u.x = cvt_pk_bf16(cr[0], -ci[0]); r.u.y = cvt_pk_bf16(cr[1], -ci[1]); r.u.z = cvt_pk_bf16(cr[2], -ci[2]); r.u.w = cvt_pk_bf16(cr[3], -ci[3]);
    k.Cc[ks] = r.v;
  }
  k.lr = p.lam[g * 64 + lane]; k.li = p.lam[4096 + g * 64 + lane];
  k.dsk = p.s5_d[g * 16 + fr];
}

template <bool FULL>
__device__ __forceinline__ void s5_segment(const Params& p, const S5Consts& k, const int tok0, const int L, const int g, float& hr, float& hi,
                                           char* wl, const int lane) {
  const int fr = lane & 15, fq = lane >> 4;
  float* bu_s = (float*)wl;
  bf16_t* h_s = (bf16_t*)(wl + 8448);
  bf16_t* u_s = (bf16_t*)(wl + 12800);
  const bf16_t* u = (const bf16_t*)p.big;
  const u32x4 zero4 = {0u, 0u, 0u, 0u};
  const bf16_t* ub = u + (size_t)(tok0 + fr) * 1024 + g * 16 + (fq & 1) * 8;
#define S5_LD(c) ((fq < 2 && (c) + fr < L) ? *(const u32x4*)(ub + (size_t)(c) * 1024) : zero4)
  u32x4 q0 = S5_LD(0), q1 = S5_LD(16), q2 = S5_LD(32), q3 = S5_LD(48);
  for (int c0 = 0; c0 < L; c0 += 16) {
    const u32x4 cur = q0; q0 = q1; q1 = q2; q2 = q3; q3 = S5_LD(c0 + 64);
    union { u32x4 u4; bf16x8 v; } ua; ua.u4 = cur;
#pragma unroll
    for (int nt = 0; nt < 8; ++nt) {
      const f32x4 d = __builtin_amdgcn_mfma_f32_16x16x32_bf16(ua.v, k.Bb[nt], (f32x4){0.f, 0.f, 0.f, 0.f}, 0, 0, 0);
#pragma unroll
      for (int j = 0; j < 4; ++j) bu_s[(fq * 4 + j) * 132 + nt * 16 + fr] = d[j];
    }
    if (FULL && fq < 2) *(u32x4*)(u_s + fr * 16 + fq * 8) = cur;
    lds_fence();
    const int nsteps = (L - c0) < 16 ? (L - c0) : 16;
    f32x2 bu[16];
#pragma unroll
    for (int tt = 0; tt < 16; ++tt) bu[tt] = *(const f32x2*)(bu_s + tt * 132 + 2 * lane);
#pragma unroll
    for (int tt = 0; tt < 16; ++tt) {
      if (tt < nsteps) {
        const float nr = k.lr * hr - k.li * hi + bu[tt][0];
        const float ni = k.lr * hi + k.li * hr + bu[tt][1];
        hr = nr; hi = ni;
      }
      if (FULL) ((unsigned*)h_s)[tt * 68 + lane] = cvt_pk_bf16(hr, hi);
    }
    lds_fence();
    if (FULL) {
      f32x4 y = {0.f, 0.f, 0.f, 0.f};
#pragma unroll
      for (int ks = 0; ks < 4; ++ks) {
        const bf16x8 ha = *(const bf16x8*)(h_s + fr * 136 + ks * 32 + fq * 8);
        y = __builtin_amdgcn_mfma_f32_16x16x32_bf16(ha, k.Cc[ks], y, 0, 0, 0);
      }
#pragma unroll
      for (int j = 0; j < 4; ++j) {
        const int tt = fq * 4 + j;
        if (c0 + tt < L) {
          const float yy = y[j] + k.dsk * bf2f(u_s[tt * 16 + fr]);
          const float z = yy / (1.0f + __expf(-1.5957691216057308f * (yy + 0.044715f * yy * yy * yy)));
          p.a1[(size_t)(tok0 + c0 + tt) * 1024 + g * 16 + fr] = f2bf(z);
        }
      }
      lds_fence();
    }
  }
#undef S5_LD
}

__device__ __forceinline__ void s5_phase(const Params& p, char* smem) {
  const int tid = threadIdx.x, lane = tid & 63, wid = tid >> 6;
  char* wl = smem + wid * 14336;
  float* carry = (float*)(smem + 114688);
  for (int pb = blockIdx.x * 2; pb < 512; pb += gridDim.x * 2) {
    const int pl = wid >> 2, seg = wid & 3, pair = pb + pl;
    const int b = pair >> 6, g = pair & 63;
    const int tok0 = b * 2048 + seg * 512;
    S5Consts k; s5_load_consts(p, g, lane, k);
    float hr = 0.f, hi = 0.f;
    s5_segment<false>(p, k, tok0, 512, g, hr, hi, wl, lane);
    __syncthreads();
    carry[((pl * 4 + seg) * 2 + 0) * 64 + lane] = hr; carry[((pl * 4 + seg) * 2 + 1) * 64 + lane] = hi;
    __syncthreads();
    float pr = k.lr, pi = k.li;
#pragma unroll
    for (int i = 0; i < 9; ++i) { const float tr = pr * pr - pi * pi, ti = 2.0f * pr * pi; pr = tr; pi = ti; }
    hr = 0.f; hi = 0.f;
    for (int s2 = 0; s2 < seg; ++s2) {
      const float fr_ = carry[((pl * 4 + s2) * 2 + 0) * 64 + lane], fi_ = carry[((pl * 4 + s2) * 2 + 1) * 64 + lane];
      const float nr = pr * hr - pi * hi + fr_, ni = pr * hi + pi * hr + fi_;
      hr = nr; hi = ni;
    }
    s5_segment<true>(p, k, tok0, 512, g, hr, hi, wl, lane);
    if (seg == 3) {
      p.out[OFF_S5RP + (size_t)(b * 64 + g) * 64 + lane] = hr; p.out[OFF_S5IP + (size_t)(b * 64 + g) * 64 + lane] = hi;
    }
    __syncthreads();
  }
  const int gw = wid * gridDim.x + blockIdx.x, nw = gridDim.x * 8;
  const bool same_g = (nw & 63) == 0;
  S5Consts ks;
  if (same_g && gw < 8192) s5_load_consts(p, gw & 63, lane, ks);
  for (int it = gw; it < 8192; it += nw) {
    const int b = it >> 6, g = it & 63;
    if (!same_g) s5_load_consts(p, g, lane, ks);
    float hr = p.s5_re[(size_t)(b * 64 + g) * 64 + lane], hi = p.s5_im[(size_t)(b * 64 + g) * 64 + lane];
    s5_segment<true>(p, ks, TP + b * 4, 4, g, hr, hi, wl, lane);
    p.out[OFF_S5RS + (size_t)(b * 64 + g) * 64 + lane] = hr; p.out[OFF_S5IS + (size_t)(b * 64 + g) * 64 + lane] = hi;
  }
}

#define XB_TMO      128
#define XB_XCNT(j)  (256  + 64 * (j))
#define XB_XSUB(j)  (1280 + 64 * (j))
#define XB_XGEN(j)  (2304 + 64 * (j))
#define XB_TOP      3328
#define XB_TOPGEN   3392
#define XCD_BAR_WORDS 3456
#define XB_SPIN_CAP (1u << 18)
__device__ __forceinline__ unsigned xb_ld(unsigned* p)              { return __hip_atomic_load(p, __ATOMIC_RELAXED, __HIP_MEMORY_SCOPE_AGENT); }
__device__ __forceinline__ unsigned xb_add(unsigned* p, unsigned v) { return __hip_atomic_fetch_add(p, v, __ATOMIC_RELAXED, __HIP_MEMORY_SCOPE_AGENT); }
__device__ __forceinline__ unsigned xb_xcc_id() { return (unsigned)__builtin_amdgcn_s_getreg((3 << 11) | 20) & 0xFu; }
#define XB_SPIN(cond, bar) do { unsigned _sp = 0; while (cond) { __builtin_amdgcn_s_sleep(1); \
    if ((++_sp & 255u) == 0u) { if (xb_ld(&(bar)[XB_TMO])) break; if (_sp > XB_SPIN_CAP) { atomicAdd(&(bar)[XB_TMO], 1u); break; } } } } while (0)
struct XcdBarrier { unsigned* bar; unsigned x; volatile LAS unsigned* st; };
__device__ __forceinline__ XcdBarrier xcd_barrier_post(unsigned* bar, volatile LAS unsigned* st) {
  XcdBarrier b; b.bar = bar; b.x = xb_xcc_id(); b.st = st;
  if (threadIdx.x == 0) (void)xb_add(&bar[XB_XCNT(b.x)], 1u);
  return b;
}
__device__ __forceinline__ void xcd_barrier_complete(unsigned* bar, unsigned x, unsigned& nloc, unsigned& nx) {
  const unsigned G = gridDim.x * gridDim.y * gridDim.z;
  unsigned sum, cnt, mine, sp = 0u;
  for (;;) {
    sum = 0u; cnt = 0u; mine = 0u;
#pragma unroll
    for (unsigned j = 0; j < 16; ++j) { const unsigned c = xb_ld(&bar[XB_XCNT(j)]); sum += c; cnt += (c > 0u) ? 1u : 0u; mine = (j == x) ? c : mine; }
    if (sum == G) break;
    __builtin_amdgcn_s_sleep(1);
    if ((++sp & 255u) == 0u) { if (xb_ld(&bar[XB_TMO])) break; if (sp > XB_SPIN_CAP) { atomicAdd(&bar[XB_TMO], 1u); break; } }
  }
  nloc = mine > 0u ? mine : 1u; nx = cnt > 0u ? cnt : 1u;
}
__device__ __forceinline__ void xcd_barrier(const XcdBarrier& b) {
  asm volatile("s_waitcnt vmcnt(0)" ::: "memory");
  __syncthreads();
  if (threadIdx.x == 0) {
    unsigned* bar = b.bar;
    __builtin_amdgcn_s_waitcnt(0);
    unsigned nloc = b.st[0], nx = b.st[1];
    if (nloc == 0u) { xcd_barrier_complete(bar, b.x, nloc, nx); b.st[0] = nloc; b.st[1] = nx; }
    const unsigned old = xb_add(&bar[XB_XSUB(b.x)], 1u);
    const unsigned gen = old / nloc;
    if (old + 1u == (gen + 1u) * nloc) {
      __builtin_amdgcn_fence(__ATOMIC_RELEASE, "agent");
      asm volatile("s_waitcnt vmcnt(0)" ::: "memory");
      const unsigned og = xb_add(&bar[XB_TOP], 1u);
      const unsigned tg = og / nx;
      if (og + 1u == (tg + 1u) * nx) xb_add(&bar[XB_TOPGEN], 1u);
      else XB_SPIN(xb_ld(&bar[XB_TOPGEN]) == tg, bar);
      __builtin_amdgcn_fence(__ATOMIC_ACQUIRE, "agent");
      xb_add(&bar[XB_XGEN(b.x)], 1u);
      asm volatile("s_waitcnt vmcnt(0)" ::: "memory");
    } else {
      XB_SPIN(xb_ld(&bar[XB_XGEN(b.x)]) == gen, bar);
      __builtin_amdgcn_fence(__ATOMIC_ACQUIRE, "agent");
      asm volatile("s_waitcnt vmcnt(0)" ::: "memory");
    }
  }
  __syncthreads();
}
#define grid_sync() xcd_barrier(xbar)

#ifndef DOUBLE_MASK
#define DOUBLE_MASK 0
#endif
#define PHASE(k, call) \
  if (p.phase_lo <= (k) && (k) < p.phase_hi) { if ((DOUBLE_MASK >> (k)) & 1) { call; grid_sync(); } call; if ((k) + 1 < p.phase_hi) grid_sync(); }

#define STAGGER(main_call, sample_call) \
  [&]() { if (blockIdx.x & 1) { sample_call; main_call; } else { main_call; sample_call; } }()

__global__ void __launch_bounds__(512, 2) mega_kernel(Params p) {
  extern __shared__ __attribute__((aligned(16))) char smem[];
  LAS unsigned char* lds = (LAS unsigned char*)smem;
  volatile LAS unsigned* xst = (volatile LAS unsigned*)(lds + 131072);
  if (threadIdx.x < 4) xst[threadIdx.x] = 0u;
  __syncthreads();
  const XcdBarrier xbar = xcd_barrier_post(p.bar, xst);
  if (p.phase_lo == 12345) cg::this_grid().sync();
  PHASE(0, (transpose_tiles(p, smem), s5_consts(p), norm0_rows(p)))
  PHASE(1, (gemm_phase<0>(lds, p.a1, p.wt_gla_in, TP, PS, 1024, p.big, PS), sgemm_sample<0, 1024>(p.a1, p.wt_gla_in, PS, p.big, PS, smem, (gridDim.x == 256) ? 64 : 0)))
  PHASE(2, (gla_prep(p, smem), __syncthreads()))
  PHASE(3, gla_phase(p, smem))
  PHASE(4, gla_gate_rows(p))
  PHASE(5, STAGGER((gemm_phase<0>(lds, p.a1, p.wt_gla_out, TP, 1024, 1024, p.big, 1024)), (sgemm_sample<0, 1024>(p.a1, p.wt_gla_out, 1024, p.big, 1024, smem))))
  PHASE(6, rows_update(p, (const bf16_t*)p.big, p.g_post_mix, p.g_pre_mlp))
  PHASE(7, STAGGER((gemm_phase<1>(lds, p.a1, p.wt_up, TP, 4096, 1024, p.big, 4096)), (sgemm_sample<1, 1024, 4>(p.a1, p.wt_up, 4096, p.big, 4096, smem))))
  PHASE(8, STAGGER((gemm_phase<0>(lds, (const bf16_t*)p.big, p.wt_down, TP, 1024, 4096, p.a1, 1024)), (sgemm_sample<0, 4096>((const bf16_t*)p.big, p.wt_down, 1024, p.a1, 1024, smem))))
  PHASE(9, rows_update(p, p.a1, p.g_post_mlp, p.g_pre_mix + 1024))
  PHASE(10, STAGGER((gemm_phase<0>(lds, p.a1, p.wt_s5_in, TP, 1024, 1024, p.big, 1024)), (sgemm_sample<0, 1024>(p.a1, p.wt_s5_in, 1024, p.big, 1024, smem))))
  PHASE(11, s5_phase(p, smem))
  PHASE(12, STAGGER((gemm_phase<3>(lds, p.a1, p.wt_glu, TP, 2048, 1024, p.big, 1024)), (sgemm_sample<3, 1024, 4>(p.a1, p.wt_glu, 2048, p.big, 1024, smem))))
  PHASE(13, rows_update(p, (const bf16_t*)p.big, p.g_post_mix + 1024, p.g_pre_mlp + 1024))
  PHASE(14, STAGGER((gemm_phase<1>(lds, p.a1, p.wt_up + (size_t)4096 * 1024, TP, 4096, 1024, p.big, 4096)), (sgemm_sample<1, 1024, 4>(p.a1, p.wt_up + (size_t)4096 * 1024, 4096, p.big, 4096, smem))))
  PHASE(15, STAGGER((gemm_phase<0>(lds, (const bf16_t*)p.big, p.wt_down + (size_t)4096 * 1024, TP, 1024, 4096, p.a1, 1024)), (sgemm_sample<0, 4096>((const bf16_t*)p.big, p.wt_down + (size_t)4096 * 1024, 1024, p.a1, 1024, smem))))
  PHASE(16, rows_update(p, p.a1, p.g_post_mlp + 1024, nullptr))
}

extern "C" void kernel_launch(void* const* d_in, const int* in_sizes, int n_in, void* d_out, int out_size, void* d_ws,
                              size_t ws_size, hipStream_t stream) {
  (void)in_sizes; (void)n_in; (void)out_size; (void)ws_size;
  Params p{};
  p.x_prompt = (const float*)d_in[0]; p.x_sample = (const float*)d_in[1]; p.state_gla = (const float*)d_in[2];
  p.s5_re = (const float*)d_in[3]; p.s5_im = (const float*)d_in[4];
  p.g_pre_mix = (const float*)d_in[5]; p.g_post_mix = (const float*)d_in[6]; p.g_pre_mlp = (const float*)d_in[7]; p.g_post_mlp = (const float*)d_in[8];
  p.w_up = (const float*)d_in[9]; p.w_down = (const float*)d_in[10]; p.gla_w_in = (const float*)d_in[11];
  p.gla_w_gate_up = (const float*)d_in[12]; p.gla_b_gate = (const float*)d_in[13]; p.gla_g_head = (const float*)d_in[14]; p.gla_w_out = (const float*)d_in[15];
  p.s5_w_in = (const float*)d_in[16]; p.s5_a_re = (const float*)d_in[17]; p.s5_a_im = (const float*)d_in[18]; p.s5_log_step = (const float*)d_in[19];
  p.s5_b_re = (const float*)d_in[20]; p.s5_b_im = (const float*)d_in[21]; p.s5_c_re = (const float*)d_in[22]; p.s5_c_im = (const float*)d_in[23];
  p.s5_d = (const float*)d_in[24]; p.s5_glu_a = (const float*)d_in[25]; p.s5_glu_b = (const float*)d_in[26];
  p.out = (float*)d_out;
  char* ws = (char*)d_ws;
  p.wt_gla_in = (bf16_t*)(ws + 0);
  p.wt_gla_out = (bf16_t*)(ws + 6815744);
  p.wt_up = (bf16_t*)(ws + 8912896);
  p.wt_down = (bf16_t*)(ws + 25690112);
  p.wt_s5_in = (bf16_t*)(ws + 42467328);
  p.wt_glu = (bf16_t*)(ws + 44564480);
  p.lam = (float*)(ws + 48758784);
  p.bb = (float*)(ws + 48791552);
  p.a1 = (bf16_t*)(ws + 49315840);
  p.big = ws + 83918848;
  p.bar = (unsigned*)(ws + 222330880);
  p.xr = (bf16_t*)(ws + 222344704);

  static int grid_blocks = 0;
  if (!grid_blocks) {
    int dev = 0, cus = 0, per_cu = 0;
    (void)hipGetDevice(&dev);
    (void)hipDeviceGetAttribute(&cus, hipDeviceAttributeMultiprocessorCount, dev);
    (void)hipFuncSetAttribute((const void*)mega_kernel, hipFuncAttributeMaxDynamicSharedMemorySize, LDS_BYTES);
    (void)hipOccupancyMaxActiveBlocksPerMultiprocessor(&per_cu, mega_kernel, 512, LDS_BYTES);
    if (per_cu > 1) per_cu = 1;
    if (per_cu < 1) per_cu = 1;
    if (cus <= 0) cus = 256;
    grid_blocks = cus * per_cu;
  }
#if ONE_LAUNCH
  p.phase_lo = 0; p.phase_hi = NPHASE;
  (void)hipMemsetAsync(p.bar, 0, XCD_BAR_WORDS * 4, stream);
  void* args[] = {&p};
  hipError_t e = hipLaunchCooperativeKernel((void*)mega_kernel, dim3(grid_blocks), dim3(512), args, LDS_BYTES, stream);
  if (e != hipSuccess) fprintf(stderr, "cooperative launch failed: %s (grid %d)\n", hipGetErrorString(e), grid_blocks);
#endif
}
```

```cpp
#include <hip/hip_runtime.h>
#include <hip/hip_cooperative_groups.h>
#include <cstdio>
namespace cg = cooperative_groups;

#ifndef ONE_LAUNCH
#define ONE_LAUNCH 1
#endif

typedef unsigned short bf16_t;
typedef short bf16x8 __attribute__((ext_vector_type(8)));
typedef float f32x4 __attribute__((ext_vector_type(4)));
typedef unsigned u32x4 __attribute__((ext_vector_type(4)));
typedef unsigned u32x2 __attribute__((ext_vector_type(2)));

constexpr int TP = 16384;
constexpr int T = 16896;
constexpr int PS = 3328;
#define LAS __attribute__((address_space(3)))
constexpr int LDS_BYTES = 131072 + 16;
constexpr float EPS = 1e-6f;
constexpr int NPHASE = 17;

constexpr size_t OFF_Y = 0;
constexpr size_t OFF_GLA_P = 17301504;
constexpr size_t OFF_GLA_S = 18350080;
constexpr size_t OFF_S5RP = 35127296;
constexpr size_t OFF_S5IP = 35160064;
constexpr size_t OFF_S5RS = 35192832;
constexpr size_t OFF_S5IS = 35717120;

struct Params {
  const float *x_prompt, *x_sample, *state_gla, *s5_re, *s5_im;
  const float *g_pre_mix, *g_post_mix, *g_pre_mlp, *g_post_mlp;
  const float *w_up, *w_down, *gla_w_in, *gla_w_gate_up, *gla_b_gate, *gla_g_head, *gla_w_out;
  const float *s5_w_in, *s5_a_re, *s5_a_im, *s5_log_step, *s5_b_re, *s5_b_im, *s5_c_re, *s5_c_im, *s5_d, *s5_glu_a, *s5_glu_b;
  float* out;
  bf16_t *wt_gla_in, *wt_gla_out, *wt_up, *wt_down, *wt_s5_in, *wt_glu;
  float *lam, *bb;
  bf16_t* a1;
  char* big;
  unsigned* bar;
  bf16_t* xr;
  int phase_lo, phase_hi;
};

typedef float f32x2 __attribute__((ext_vector_type(2)));
typedef __bf16 bf16x2_t __attribute__((ext_vector_type(2)));
__device__ __forceinline__ unsigned cvt_pk_bf16(float lo, float hi) {
  const f32x2 v = {lo, hi};
  const bf16x2_t b = __builtin_convertvector(v, bf16x2_t);
  return __builtin_bit_cast(unsigned, b);
}
__device__ __forceinline__ float bf2f(bf16_t v) { return __uint_as_float(((unsigned)v) << 16); }
__device__ __forceinline__ float bflo(unsigned w) { return __uint_as_float(w << 16); }
__device__ __forceinline__ float bfhi(unsigned w) { return __uint_as_float(w & 0xffff0000u); }
__device__ __forceinline__ bf16_t f2bf(float f) { return (bf16_t)(cvt_pk_bf16(f, 0.f) & 0xffffu); }

__device__ __forceinline__ float wave_sum(float v) {
  v += __shfl_xor(v, 32); v += __shfl_xor(v, 16); v += __shfl_xor(v, 8);
  v += __shfl_xor(v, 4);  v += __shfl_xor(v, 2);  v += __shfl_xor(v, 1);
  return v;
}
__device__ __forceinline__ void lds_fence() { asm volatile("s_waitcnt lgkmcnt(0)" ::: "memory"); }

__device__ void transpose_tiles(const Params& p, char* smem) {
  const int sub = threadIdx.x >> 8, tid = threadIdx.x & 255;
  float* ts = (float*)(smem + sub * 32768);
  for (int base = blockIdx.x * 2; base < 5952; base += gridDim.x * 2) {
    int t = base + sub; const float* src; int ld, K, nvalid; bf16_t* dst; int glu = 0;
    if (t < 832) { src = p.gla_w_in; ld = 3088; K = 1024; nvalid = 3088; dst = p.wt_gla_in; }
    else if ((t -= 832) < 256) { src = p.gla_w_out; ld = 1024; K = 1024; nvalid = 1024; dst = p.wt_gla_out; }
    else if ((t -= 256) < 2048) { int l = t >> 10; t &= 1023; src = p.w_up + (size_t)l * 1024 * 4096; ld = 4096; K = 1024; nvalid = 4096; dst = p.wt_up + (size_t)l * 4096 * 1024; }
    else if ((t -= 2048) < 2048) { int l = t >> 10; t &= 1023; src = p.w_down + (size_t)l * 4096 * 1024; ld = 1024; K = 4096; nvalid = 1024; dst = p.wt_down + (size_t)l * 1024 * 4096; }
    else if ((t -= 2048) < 256) { src = p.s5_w_in; ld = 1024; K = 1024; nvalid = 1024; dst = p.wt_s5_in; }
    else { t -= 256; src = p.s5_glu_a; ld = 1024; K = 1024; nvalid = 2048; dst = p.wt_glu; glu = 1; }
    const int ktiles = K >> 6;
    const int nt = t / ktiles, kt = t - nt * ktiles;
    const int n0 = nt * 64, k0 = kt * 64;
    const int nl = tid & 63, kl = tid >> 6;
    const int n = n0 + nl;
    const float* cp = nullptr;
    if (glu) {
      const int col = (n >> 5) * 16 + (n & 15);
      cp = (((n >> 4) & 1) ? p.s5_glu_b : p.s5_glu_a) + col;
    } else if (n < nvalid) cp = src + n;
    __syncthreads();
float tv[16];
#pragma unroll
    for (int i = 0; i < 16; ++i) tv[i] = cp ? cp[(size_t)(k0 + kl + 4 * i) * ld] : 0.f;
#pragma unroll
    for (int i = 0; i < 16; ++i) ts[(kl + 4 * i) * 65 + nl] = tv[i];
    __syncthreads();
    const int k8 = (tid & 7) * 8;
#pragma unroll
    for (int i = 0; i < 2; ++i) {
      const int nn = (tid >> 3) + 32 * i;
      u32x4 w;
      w.x = cvt_pk_bf16(ts[(k8 + 0) * 65 + nn], ts[(k8 + 1) * 65 + nn]);
      w.y = cvt_pk_bf16(ts[(k8 + 2) * 65 + nn], ts[(k8 + 3) * 65 + nn]);
      w.z = cvt_pk_bf16(ts[(k8 + 4) * 65 + nn], ts[(k8 + 5) * 65 + nn]);
      w.w = cvt_pk_bf16(ts[(k8 + 6) * 65 + nn], ts[(k8 + 7) * 65 + nn]);
      *(u32x4*)(dst + (size_t)(n0 + nn) * K + k0 + k8) = w;
    }
  }
}

__device__ void s5_consts(const Params& p) {
  for (int i = blockIdx.x * 512 + threadIdx.x; i < 4096; i += gridDim.x * 512) {
    const int g = i >> 6;
    const float ar = p.s5_a_re[i], ai = p.s5_a_im[i];
    const float dt = expf(p.s5_log_step[g]);
    const float mag = expf(ar * dt);
    const float lr = mag * cosf(ai * dt), li = mag * sinf(ai * dt);
    const float nr = lr - 1.0f, ni = li;
    const float den = ar * ar + ai * ai;
    const float zr = (nr * ar + ni * ai) / den;
    const float zi = (ni * ar - nr * ai) / den;
    p.lam[i] = lr; p.lam[4096 + i] = li;
#pragma unroll
    for (int c = 0; c < 16; ++c) {
      const float br = p.s5_b_re[i * 16 + c], bi = p.s5_b_im[i * 16 + c];
      p.bb[i * 16 + c] = zr * br - zi * bi;
      p.bb[65536 + i * 16 + c] = zr * bi + zi * br;
    }
  }
}

__device__ void norm0_rows(const Params& p) {
  const int lane = threadIdx.x & 63, wid = threadIdx.x >> 6;
  for (int row = blockIdx.x * 8 + wid; row < T; row += gridDim.x * 8) {
    const float* xr = (row < TP) ? p.x_prompt + (size_t)row * 1024 : p.x_sample + (size_t)(row - TP) * 1024;
    f32x4 v[4]; float ss = 0.f;
#pragma unroll
    for (int i = 0; i < 4; ++i) { v[i] = *(const f32x4*)(xr + i * 256 + lane * 4); ss += v[i][0] * v[i][0] + v[i][1] * v[i][1] + v[i][2] * v[i][2] + v[i][3] * v[i][3]; }
    ss = wave_sum(ss);
    const float r = rsqrtf(ss * (1.0f / 1024.0f) + EPS);
#pragma unroll
    for (int i = 0; i < 4; ++i) {
      const f32x4 g = *(const f32x4*)(p.g_pre_mix + i * 256 + lane * 4);
      u32x2 w; w.x = cvt_pk_bf16(v[i][0] * r * g[0], v[i][1] * r * g[1]); w.y = cvt_pk_bf16(v[i][2] * r * g[2], v[i][3] * r * g[3]);
      *(u32x2*)(p.a1 + (size_t)row * 1024 + i * 256 + lane * 4) = w;
      u32x2 xw; xw.x = cvt_pk_bf16(v[i][0], v[i][1]); xw.y = cvt_pk_bf16(v[i][2], v[i][3]);
      *(u32x2*)(p.xr + (size_t)row * 1024 + i * 256 + lane * 4) = xw;
    }
  }
}

__device__ void rows_update(const Params& p, const bf16_t* msrc, const float* gpost, const float* gnext) {
  const int lane = threadIdx.x & 63, wid = threadIdx.x >> 6;
  const int nwav = gridDim.x * 8;
  f32x4 gp[4], gn[4];
#pragma unroll
  for (int i = 0; i < 4; ++i) {
    gp[i] = *(const f32x4*)(gpost + i * 256 + lane * 4);
    gn[i] = gnext ? *(const f32x4*)(gnext + i * 256 + lane * 4) : (f32x4){0.f, 0.f, 0.f, 0.f};
  }
  for (int row0 = blockIdx.x * 8 + wid; row0 < T; row0 += 2 * nwav) {
    u32x2 mw[2][4], xw[2][4]; bool ok[2];
#pragma unroll
    for (int r = 0; r < 2; ++r) {
      const int row = row0 + r * nwav; ok[r] = row < T;
      if (ok[r]) {
#pragma unroll
        for (int i = 0; i < 4; ++i) { mw[r][i] = *(const u32x2*)(msrc + (size_t)row * 1024 + i * 256 + lane * 4); xw[r][i] = *(const u32x2*)(p.xr + (size_t)row * 1024 + i * 256 + lane * 4); }
      }
    }
#pragma unroll
    for (int r = 0; r < 2; ++r) {
      if (!ok[r]) continue;
      const int row = row0 + r * nwav;
      f32x4 m[4]; float ss = 0.f;
#pragma unroll
      for (int i = 0; i < 4; ++i) {
        m[i][0] = bflo(mw[r][i].x); m[i][1] = bfhi(mw[r][i].x); m[i][2] = bflo(mw[r][i].y); m[i][3] = bfhi(mw[r][i].y);
        ss += m[i][0] * m[i][0] + m[i][1] * m[i][1] + m[i][2] * m[i][2] + m[i][3] * m[i][3];
      }
      ss = wave_sum(ss);
      const float rs = rsqrtf(ss * (1.0f / 1024.0f) + EPS);
      float ss2 = 0.f;
#pragma unroll
      for (int i = 0; i < 4; ++i) {
        const float x0 = bflo(xw[r][i].x), x1 = bfhi(xw[r][i].x), x2 = bflo(xw[r][i].y), x3 = bfhi(xw[r][i].y);
        m[i][0] = x0 + m[i][0] * rs * gp[i][0]; m[i][1] = x1 + m[i][1] * rs * gp[i][1];
        m[i][2] = x2 + m[i][2] * rs * gp[i][2]; m[i][3] = x3 + m[i][3] * rs * gp[i][3];
        ss2 += m[i][0] * m[i][0] + m[i][1] * m[i][1] + m[i][2] * m[i][2] + m[i][3] * m[i][3];
        if (gnext) {
          u32x2 w; w.x = cvt_pk_bf16(m[i][0], m[i][1]); w.y = cvt_pk_bf16(m[i][2], m[i][3]);
          *(u32x2*)(p.xr + (size_t)row * 1024 + i * 256 + lane * 4) = w;
        } else {
          *(f32x4*)(p.out + OFF_Y + (size_t)row * 1024 + i * 256 + lane * 4) = m[i];
        }
      }
      if (gnext) {
        ss2 = wave_sum(ss2);
        const float r2 = rsqrtf(ss2 * (1.0f / 1024.0f) + EPS);
#pragma unroll
        for (int i = 0; i < 4; ++i) {
          u32x2 w; w.x = cvt_pk_bf16(m[i][0] * r2 * gn[i][0], m[i][1] * r2 * gn[i][1]); w.y = cvt_pk_bf16(m[i][2] * r2 * gn[i][2], m[i][3] * r2 * gn[i][3]);
          *(u32x2*)(p.a1 + (size_t)row * 1024 + i * 256 + lane * 4) = w;
        }
      }
    }
  }
}

constexpr int G_BM = 256, G_BK = 64, G_HALF = 128, G_HTB = G_HALF * G_BK * 2;
__device__ __forceinline__ int g_lds_byte(int r, int c) { const int st = (r >> 4) * 2 + (c >> 5), rr = r & 15, cc = c & 31, ob = rr * 64 + cc * 2; return st * 1024 + (ob ^ (((ob >> 9) & 1) << 5)); }
__device__ __forceinline__ void g_stage_rc(int b, int& R, int& C) { const int st = b / 1024, sb = b % 1024, swz = sb ^ (((sb >> 9) & 1) << 5); R = (st >> 1) * 16 + swz / 64; C = (st & 1) * 32 + (swz % 64) / 2; }
struct Unit { int pm, pn; };
__device__ __forceinline__ bool g_next(int i, int nM, int nN, int nwg, int G, int c, Unit& u) {
  const long L = (long)i * G + c; if (L >= nwg) return false;
  int wgid = (int)L; { const int q = nwg / 8, r = nwg % 8, xcd = wgid % 8, off = wgid / 8; wgid = (xcd < r ? xcd * (q + 1) : r * (q + 1) + (xcd - r) * q) + off; }
  const int nig = 8 * nN, gid = wgid / nig, fm = gid * 8, gsz = (nM - fm) < 8 ? (nM - fm) : 8;
  u.pm = fm + ((wgid % nig) % gsz); u.pn = (wgid % nig) / gsz; return true;
}

template <int EPI>
__device__ __forceinline__ void gemm_epilogue(const f32x4 (&acc)[2][2][4][2], const Unit& u, int wr, int wc, int fr, int fq, void* outp, int ldo) {
  const int row0 = u.pm * G_BM + wr * 64 + fr;
#pragma unroll
  for (int ai = 0; ai < 2; ++ai)
#pragma unroll
    for (int m = 0; m < 4; ++m) {
      const size_t row = (size_t)(row0 + ai * G_HALF + m * 16);
#pragma unroll
      for (int bj = 0; bj < 2; ++bj) {
        if (EPI == 3) {
          const int col = u.pn * 128 + bj * 64 + wc * 16 + 4 * fq;
          const f32x4 a = acc[ai][bj][m][0], b = acc[ai][bj][m][1]; f32x4 o;
#pragma unroll
          for (int j = 0; j < 4; ++j) o[j] = a[j] / (1.0f + __expf(-b[j]));
          u32x2 w; w.x = cvt_pk_bf16(o[0], o[1]); w.y = cvt_pk_bf16(o[2], o[3]);
          *(u32x2*)((bf16_t*)outp + row * ldo + col) = w;
        } else if (EPI == 2) {
#pragma unroll
          for (int n = 0; n < 2; ++n) {
            const int col = u.pn * G_BM + wc * 32 + 4 * fq + bj * G_HALF + n * 16;
            *(f32x4*)((float*)outp + row * ldo + col) = acc[ai][bj][m][n];
          }
        } else {
          const int col = u.pn * G_BM + wc * 32 + 8 * fq + bj * G_HALF;
          f32x4 v0 = acc[ai][bj][m][0], v1 = acc[ai][bj][m][1];
          if (EPI == 1) {
#pragma unroll
            for (int j = 0; j < 4; ++j) { const float t0 = fmaxf(v0[j], 0.f), t1 = fmaxf(v1[j], 0.f); v0[j] = t0 * t0; v1[j] = t1 * t1; }
          }
          u32x4 w; w.x = cvt_pk_bf16(v0[0], v0[1]); w.y = cvt_pk_bf16(v0[2], v0[3]); w.z = cvt_pk_bf16(v1[0], v1[1]); w.w = cvt_pk_bf16(v1[2], v1[3]);
          *(u32x4*)((bf16_t*)outp + row * ldo + col) = w;
        }
      }
    }
}

template <int EPI>
__device__ __forceinline__ void gemm_phase(LAS unsigned char* lds, const bf16_t* gA, const bf16_t* gBt, const int M, const int N, const int K, void* outp, const int ldo) {
  const int tid = threadIdx.x, wid = __builtin_amdgcn_readfirstlane(tid >> 6), lane = tid & 63, wr = wid >> 2, wc = wid & 3, fr = lane & 15, fq = lane >> 4;
  const int nt = K / G_BK;
  const int nM = M / G_BM, nN = N / G_BM, nwg = nM * nN, G = (int)gridDim.x, c = (int)blockIdx.x;
  constexpr bool PERM = (EPI == 0 || EPI == 1);
  unsigned voffA[2], voffB[2];
#pragma unroll
  for (int i = 0; i < 2; ++i) { int R, C; g_stage_rc(tid * 16 + i * 8192, R, C);
    int Rb = R; if (PERM) { const int rho = R & 31, nn = rho >> 4, ii = rho & 15; Rb = (R & ~31) + 8 * (ii >> 2) + 4 * nn + (ii & 3); }
    voffA[i] = (unsigned)(R * K + C) * 2u; voffB[i] = (unsigned)(Rb * K + C) * 2u; }
  const size_t kstep = (size_t)(G_BK * 2);
  const size_t hstep = (size_t)G_HALF * K * 2;
  const size_t tstep = 2 * hstep;
  const unsigned ldsw = (unsigned)wid * 1024u;
  const int aoff = g_lds_byte(wr * 64 + fr, fq * 8), boff = g_lds_byte(wc * 32 + fr, fq * 8);
#define PG8_SA(b, h) (((b) * 2 + (h)) * G_HTB)
#define PG8_SB(b, h) ((4 + (b) * 2 + (h)) * G_HTB)
#define PG8_STAGEX(bufoff, gbase, voff) do { _Pragma("unroll") for (int _i = 0; _i < 2; ++_i) \
    __builtin_amdgcn_global_load_lds((const unsigned*)((const char*)(gbase) + (voff)[_i]), (LAS unsigned*)(lds + (bufoff) + ldsw + _i * 8192), 16, 0, 0); } while (0)
#define PG8_LDA(dst, b, h) do { _Pragma("unroll") for (int m = 0; m < 4; ++m) _Pragma("unroll") for (int k = 0; k < 2; ++k) dst[m][k] = *(const LAS bf16x8*)(lds + PG8_SA(b, h) + aoff + m * 2048 + k * 1024); } while (0)
#define PG8_LDB(dst, b, h) do { _Pragma("unroll") for (int n = 0; n < 2; ++n) _Pragma("unroll") for (int k = 0; k < 2; ++k) dst[n][k] = *(const LAS bf16x8*)(lds + PG8_SB(b, h) + boff + n * 2048 + k * 1024); } while (0)
#define PG8_MMA(ai, bj, At, Bt) do { __builtin_amdgcn_s_setprio(1); _Pragma("unroll") for (int m = 0; m < 4; ++m) _Pragma("unroll") for (int n = 0; n < 2; ++n) _Pragma("unroll") for (int k = 0; k < 2; ++k) \
    acc[ai][bj][m][n] = __builtin_amdgcn_mfma_f32_16x16x32_bf16(Bt[n][k], At[m][k], acc[ai][bj][m][n], 0, 0, 0); __builtin_amdgcn_s_setprio(0); } while (0)
#define PG8_WAIT_V(n) asm volatile("s_waitcnt vmcnt(" #n ")" ::: "memory")
#define PG8_WAIT_L(n) asm volatile("s_waitcnt lgkmcnt(" #n ")" ::: "memory")
#define PG8_BAR __builtin_amdgcn_s_barrier()
#define PG8_SCHED __builtin_amdgcn_sched_barrier(0)
  Unit cur, nxt; int ui = 0;
  if (!g_next(0, nM, nN, nwg, G, c, cur)) return;
  f32x4 acc[2][2][4][2];
#pragma unroll
  for (int a = 0; a < 2; ++a)
#pragma unroll
    for (int b = 0; b < 2; ++b)
#pragma unroll
      for (int m = 0; m < 4; ++m)
#pragma unroll
        for (int n = 0; n < 2; ++n) acc[a][b][m][n] = (f32x4){0.f, 0.f, 0.f, 0.f};
  bf16x8 At[4][2], B0[2][2], B1[2][2];
  const char* cA = (const char*)gA + (size_t)cur.pm * tstep; const char* cB = (const char*)gBt + (size_t)cur.pn * tstep;
  PG8_STAGEX(PG8_SB(0, 0), cB, voffB); PG8_STAGEX(PG8_SA(0, 0), cA, voffA); PG8_STAGEX(PG8_SB(0, 1), cB + hstep, voffB); PG8_STAGEX(PG8_SA(0, 1), cA + hstep, voffA);
  if (wr == 1) PG8_BAR;
  PG8_WAIT_V(4); PG8_BAR;
  PG8_STAGEX(PG8_SB(1, 0), cB + kstep, voffB); PG8_STAGEX(PG8_SA(1, 0), cA + kstep, voffA); PG8_STAGEX(PG8_SB(1, 1), cB + hstep + kstep, voffB);
  PG8_WAIT_V(6); PG8_BAR;
  for (;;) {
    const bool has_next = g_next(ui + 1, nM, nN, nwg, G, c, nxt);
    const char* nA = has_next ? (const char*)gA + (size_t)nxt.pm * tstep : cA; const char* nB = has_next ? (const char*)gBt + (size_t)nxt.pn * tstep : cB;
    for (int t = 0; t < nt; t += 2) {
      const bool last = (t == nt - 2);
      const char* a1 = cA + (size_t)(t + 1) * kstep;
      const char* a2 = last ? nA : cA + (size_t)(t + 2) * kstep; const char* b2 = last ? nB : cB + (size_t)(t + 2) * kstep;
      const char* a3 = a2 + kstep; const char* b3 = b2 + kstep;
      PG8_LDB(B0, 0, 0); PG8_SCHED; PG8_LDA(At, 0, 0); PG8_STAGEX(PG8_SA(1, 1), a1 + hstep, voffA);
      PG8_WAIT_L(8); PG8_BAR; PG8_WAIT_L(0); PG8_MMA(0, 0, At, B0); PG8_BAR; PG8_SCHED;
      PG8_LDB(B1, 0, 1); PG8_STAGEX(PG8_SB(0, 0), b2, voffB);
      PG8_BAR; PG8_WAIT_L(0); PG8_MMA(0, 1, At, B1); PG8_BAR;
      PG8_LDA(At, 0, 1); PG8_STAGEX(PG8_SA(0, 0), a2, voffA);
      PG8_BAR; PG8_WAIT_L(0); PG8_MMA(1, 0, At, B0); PG8_BAR; PG8_SCHED;
      PG8_STAGEX(PG8_SB(0, 1), b2 + hstep, voffB);
      PG8_WAIT_V(6); PG8_BAR; PG8_MMA(1, 1, At, B1); PG8_BAR;
      PG8_LDB(B0, 1, 0); PG8_SCHED; PG8_LDA(At, 1, 0); PG8_STAGEX(PG8_SA(0, 1), a2 + hstep, voffA);
      PG8_WAIT_L(8); PG8_BAR; PG8_WAIT_L(0); PG8_MMA(0, 0, At, B0); PG8_BAR; PG8_SCHED;
      PG8_LDB(B1, 1, 1); PG8_STAGEX(PG8_SB(1, 0), b3, voffB);
      PG8_BAR; PG8_WAIT_L(0); PG8_MMA(0, 1, At, B1); PG8_BAR;
      PG8_LDA(At, 1, 1); PG8_STAGEX(PG8_SA(1, 0), a3, voffA);
      PG8_BAR; PG8_WAIT_L(0); PG8_MMA(1, 0, At, B0); PG8_BAR; PG8_SCHED;
      PG8_STAGEX(PG8_SB(1, 1), b3 + hstep, voffB);
      PG8_WAIT_V(6); PG8_BAR; PG8_MMA(1, 1, At, B1); PG8_BAR;
    }
    gemm_epilogue<EPI>(acc, cur, wr, wc, fr, fq, outp, ldo);
    if (!has_next) break;
#pragma unroll
    for (int a = 0; a < 2; ++a)
#pragma unroll
      for (int b = 0; b < 2; ++b)
#pragma unroll
        for (int m = 0; m < 4; ++m)
#pragma unroll
          for (int n = 0; n < 2; ++n) acc[a][b][m][n] = (f32x4){0.f, 0.f, 0.f, 0.f};
    cur = nxt; cA = nA; cB = nB; ++ui;
  }
  PG8_WAIT_V(0);
  if (wr == 0) PG8_BAR;
  PG8_BAR;
#undef PG8_SA
#undef PG8_SB
#undef PG8_STAGEX
#undef PG8_LDA
#undef PG8_LDB
#undef PG8_MMA
#undef PG8_WAIT_V
#undef PG8_WAIT_L
#undef PG8_BAR
#undef PG8_SCHED
}

template <int EPI, int K, int NF = 2>
__device__ void sgemm_sample(const bf16_t* __restrict__ A, const bf16_t* __restrict__ Bt, const int N, void* outp, const int ldo, char* smem, const int blk0 = 0) {
  const int tid = threadIdx.x, lane = tid & 63, w = tid >> 6, fr = lane & 15, fq = lane >> 4;
  constexpr int TW = 16 * NF;
  float* red = (float*)smem;
  const int nitems = 8 * (N / TW);
  constexpr int KW = K / 8;
  constexpr int KB = (NF == 2) ? 128 : 64;
  const int nblk = (int)gridDim.x - blk0;
  for (int it = (int)blockIdx.x - blk0; it >= 0 && it < nitems; it += nblk) {
    const int mi = it & 7, ni = it >> 3;
    const bf16_t* Ab = A + (size_t)(TP + mi * 64 + fr) * K + w * KW + fq * 8;
    const bf16_t* Bb = Bt + (size_t)(ni * TW + fr) * K + w * KW + fq * 8;
    f32x4 acc[4][NF];
#pragma unroll
    for (int i = 0; i < 4; ++i)
#pragma unroll
      for (int j = 0; j < NF; ++j) acc[i][j] = (f32x4){0.f, 0.f, 0.f, 0.f};
#pragma unroll 1
    for (int kb = 0; kb < KW; kb += KB) {
      bf16x8 af[KB / 32][4], bfv[KB / 32][NF];
#pragma unroll
      for (int ks = 0; ks < KB / 32; ++ks) {
#pragma unroll
        for (int mf = 0; mf < 4; ++mf) af[ks][mf] = *(const bf16x8*)(Ab + (size_t)(mf * 16) * K + kb + ks * 32);
#pragma unroll
        for (int nf = 0; nf < NF; ++nf) bfv[ks][nf] = *(const bf16x8*)(Bb + (size_t)(nf * 16) * K + kb + ks * 32);
      }
#pragma unroll
      for (int ks = 0; ks < KB / 32; ++ks)
#pragma unroll
        for (int mf = 0; mf < 4; ++mf)
#pragma unroll
          for (int nf = 0; nf < NF; ++nf)
            acc[mf][nf] = __builtin_amdgcn_mfma_f32_16x16x32_bf16(bfv[ks][nf], af[ks][mf], acc[mf][nf], 0, 0, 0);
    }
    __syncthreads();
#pragma unroll
    for (int mf = 0; mf < 4; ++mf)
#pragma unroll
      for (int nf = 0; nf < NF; ++nf)
        *(f32x4*)(red + ((w * 64 + mf * 16 + fr) * TW + (((nf * 4 + fq) ^ (fr & 7)) << 2))) = acc[mf][nf];
    __syncthreads();
    if (EPI == 3) {
      constexpr int GPT = TW / 32;
      for (int e = tid; e < 64 * GPT * 4; e += 512) {
        const int row = e / (GPT * 4), gq = e % (GPT * 4), gi = gq >> 2, c4 = (gq & 3) * 4;
        f32x4 a = {0.f, 0.f, 0.f, 0.f}, b = {0.f, 0.f, 0.f, 0.f};
#pragma unroll
        for (int ww = 0; ww < 8; ++ww) { a += *(const f32x4*)(red + ((ww * 64 + row) * TW + (((gi * 8 + (c4 >> 2)) ^ (row & 7)) << 2))); b += *(const f32x4*)(red + ((ww * 64 + row) * TW + (((gi * 8 + 4 + (c4 >> 2)) ^ (row & 7)) << 2))); }
        f32x4 o;
#pragma unroll
        for (int j = 0; j < 4; ++j) o[j] = a[j] / (1.0f + __expf(-b[j]));
        u32x2 pk; pk.x = cvt_pk_bf16(o[0], o[1]); pk.y = cvt_pk_bf16(o[2], o[3]);
        *(u32x2*)((bf16_t*)outp + (size_t)(TP + mi * 64 + row) * ldo + (ni * GPT + gi) * 16 + c4) = pk;
      }
    } else {
      for (int e = tid; e < 64 * (TW / 4); e += 512) {
        const int row = e / (TW / 4), c4 = (e % (TW / 4)) * 4;
        f32x4 v = {0.f, 0.f, 0.f, 0.f};
#pragma unroll
        for (int ww = 0; ww < 8; ++ww) v += *(const f32x4*)(red + ((ww * 64 + row) * TW + (((c4 >> 2) ^ (row & 7)) << 2)));
        const size_t o = (size_t)(TP + mi * 64 + row) * ldo + ni * TW + c4;
        if (EPI == 2) {
          *(f32x4*)((float*)outp + o) = v;
        } else {
          if (EPI == 1) {
#pragma unroll
            for (int j = 0; j < 4; ++j) { const float t = fmaxf(v[j], 0.f); v[j] = t * t; }
          }
          u32x2 pk; pk.x = cvt_pk_bf16(v[0], v[1]); pk.y = cvt_pk_bf16(v[2], v[3]);
          *(u32x2*)((bf16_t*)outp + o) = pk;
        }
      }
    }
  }
  __syncthreads();
}

__device__ __forceinline__ float gate_decay(float z) {
  const float ls = fminf(z, 0.f) - log1pf(expf(-fabsf(z)));
  return expf(ls * 0.0625f);
}

__device__ void gla_sample_item(const Params& p, const int item, char* smem, const int tid) {
  const int h = item & 3, b = item >> 2;
  float* wg = (float*)smem;
  float* bg = wg + 2048;
  float* gl_s = bg + 128;
  float* q_s = gl_s + 64;
  float* k_s = q_s + 512;
  float* e_s = k_s + 512;
  const bf16_t* proj = (const bf16_t*)p.big;
  const int tok0 = TP + b * 4;
  __syncthreads();
  for (int i = tid; i < 2048; i += 256) { const int r = i >> 7, k = i & 127; wg[i] = p.gla_w_gate_up[r * 512 + h * 128 + k]; }
  if (tid < 128) bg[tid] = p.gla_b_gate[h * 128 + tid];
  if (tid < 64) gl_s[tid] = bf2f(proj[(size_t)(tok0 + (tid >> 4)) * PS + 3072 + (tid & 15)]);
  for (int i = tid; i < 512; i += 256) {
    const int tt = i >> 7, k = i & 127;
    q_s[i] = bf2f(proj[(size_t)(tok0 + tt) * PS + h * 128 + k]) * 0.08838834764831845f;
    k_s[i] = bf2f(proj[(size_t)(tok0 + tt) * PS + 512 + h * 128 + k]);
  }
  float vr[4];
#pragma unroll
  for (int tt = 0; tt < 4; ++tt) vr[tt] = bf2f(proj[(size_t)(tok0 + tt) * PS + 1024 + h * 256 + tid]);
  __syncthreads();
  for (int i = tid; i < 512; i += 256) {
    const int tt = i >> 7, k = i & 127;
    float z = bg[k];
#pragma unroll
    for (int r = 0; r < 16; ++r) z += gl_s[tt * 16 + r] * wg[r * 128 + k];
    e_s[i] = gate_decay(z);
  }
  __syncthreads();
  const float* sin_ = p.state_gla + ((size_t)(b * 4 + h) * 128) * 256 + tid;
  float* sout = p.out + OFF_GLA_S + ((size_t)(b * 4 + h) * 128) * 256 + tid;
  float o[4] = {0.f, 0.f, 0.f, 0.f};
  for (int kb = 0; kb < 128; kb += 16) {
    float Sv[16];
#pragma unroll
    for (int i = 0; i < 16; ++i) Sv[i] = sin_[(size_t)(kb + i) * 256];
#pragma unroll
    for (int i = 0; i < 16; ++i) {
      const int k = kb + i;
#pragma unroll
      for (int tt = 0; tt < 4; ++tt) { Sv[i] = e_s[tt * 128 + k] * Sv[i] + k_s[tt * 128 + k] * vr[tt]; o[tt] += q_s[tt * 128 + k] * Sv[i]; }
    }
#pragma unroll
    for (int i = 0; i < 16; ++i) sout[(size_t)(kb + i) * 256] = Sv[i];
  }
#pragma unroll
  for (int tt = 0; tt < 4; ++tt) p.a1[(size_t)(tok0 + tt) * 1024 + h * 256 + tid] = f2bf(o[tt]);
}


constexpr size_t KT_OFF = (size_t)T * PS * 2;
constexpr size_t VEC_OFF = KT_OFF + (size_t)16777216;

__device__ void gla_prep(const Params& p, char* smem) {
  float* gl_s = (float*)smem;
  const int c = threadIdx.x;
  bf16_t* proj = (bf16_t*)p.big;
  bf16_t* KT = (bf16_t*)(p.big + KT_OFF);
  float* VEC = (float*)(p.big + VEC_OFF);
  float wg[16];
#pragma unroll
  for (int r = 0; r < 16; ++r) wg[r] = p.gla_w_gate_up[r * 512 + c];
  const float bias = p.gla_b_gate[c];
  for (int item = blockIdx.x; item < 256; item += gridDim.x) {
    const int tok0 = (item >> 5) * 2048 + (item & 31) * 64;
    __syncthreads();
    for (int i = threadIdx.x; i < 1024; i += 512) gl_s[i] = bf2f(proj[(size_t)(tok0 + (i >> 4)) * PS + 3072 + (i & 15)]);
    __syncthreads();
    float bc[64]; float run = 0.f;
#pragma unroll
    for (int t = 0; t < 64; ++t) {
      float z = bias;
#pragma unroll
      for (int r = 0; r < 16; ++r) z += gl_s[t * 16 + r] * wg[r];
      const float ls = fminf(z, 0.f) - __logf(1.0f + __expf(-fabsf(z)));
      run += ls * 0.0625f; bc[t] = run;
    }
    const float bref = bc[32], blast = bc[63];
    bf16_t* qp = proj + (size_t)tok0 * PS + c;
    bf16_t* kp = qp + 512;
    bf16_t* ktp = KT + ((size_t)(item * 4 + (c >> 7)) * 128 + (c & 127)) * 64;
#pragma unroll
    for (int t8 = 0; t8 < 8; ++t8) {
      float kk[8];
#pragma unroll
      for (int i = 0; i < 8; ++i) {
        const int t = t8 * 8 + i;
        const float q = bf2f(qp[(size_t)t * PS]), k = bf2f(kp[(size_t)t * PS]);
        const float qi = q * 0.08838834764831845f * __expf(bc[t] - bref);
        kk[i] = k * __expf(bref - bc[t]);
        qp[(size_t)t * PS] = f2bf(qi);
        kp[(size_t)t * PS] = f2bf(kk[i]);
      }
      u32x4 w; w.x = cvt_pk_bf16(kk[0], kk[1]); w.y = cvt_pk_bf16(kk[2], kk[3]); w.z = cvt_pk_bf16(kk[4], kk[5]); w.w = cvt_pk_bf16(kk[6], kk[7]);
      *(u32x4*)(ktp + t8 * 8) = w;
    }
    VEC[(size_t)(item * 3 + 0) * 512 + c] = __expf(bref);
    VEC[(size_t)(item * 3 + 1) * 512 + c] = __expf(blast - bref);
    VEC[(size_t)(item * 3 + 2) * 512 + c] = __expf(blast);
  }
}

__device__ __forceinline__ bf16x8 lfrag(const char* base, int row, int rowbytes, int chunk, int mask) {
  return *(const bf16x8*)(base + row * rowbytes + ((chunk ^ (row & mask)) << 4));
}

struct GlaRegs { u32x4 q[2], k[2], t[2], v; float c; };

__device__ void gla_main_item(const Params& p, const int item, char* smem) {
  const int b = item >> 4, h = (item >> 2) & 3, v0 = (item & 3) * 64;
  const int tid = threadIdx.x, lane = tid & 63, w = tid >> 6, fr = lane & 15, fq = lane >> 4;
  char* Qs = smem;
  char* Ks = smem + 16384;
  char* KTs = smem + 32768;
  char* VTs = smem + 49152;
  char* ATs = smem + 57344;
  char* HTs = smem + 65536;
  float* VCs = (float*)(smem + 81920);
  const bf16_t* proj = (const bf16_t*)p.big;
  const bf16_t* KT = (const bf16_t*)(p.big + KT_OFF);
  const float* VEC = (const float*)(p.big + VEC_OFF);
  f32x4 hacc[4];
#pragma unroll
  for (int i = 0; i < 4; ++i) hacc[i] = (f32x4){0.f, 0.f, 0.f, 0.f};
  const int qrow0 = tid >> 4, qch = tid & 15;
  const int trow0 = tid >> 3, tch = tid & 7;
  const int vt_t = tid >> 3, vt_v = (tid & 7) * 8;
  auto load_regs = [&](const int n, GlaRegs& R) {
    const int tok0 = b * 2048 + n * 64, ci = b * 32 + n;
#pragma unroll
    for (int i = 0; i < 2; ++i) {
      const bf16_t* r = proj + (size_t)(tok0 + qrow0 + 32 * i) * PS + h * 128 + qch * 8;
      R.q[i] = *(const u32x4*)r; R.k[i] = *(const u32x4*)(r + 512);
      R.t[i] = *(const u32x4*)(KT + ((size_t)(ci * 4 + h) * 128 + trow0 + 64 * i) * 64 + tch * 8);
    }
    R.v = *(const u32x4*)(proj + (size_t)(tok0 + vt_t) * PS + 1024 + h * 256 + v0 + vt_v);
    R.c = (tid < 384) ? VEC[(size_t)(ci * 3 + (tid >> 7)) * 512 + h * 128 + (tid & 127)] : 0.f;
  };
  auto store_regs = [&](const GlaRegs& R) {
#pragma unroll
    for (int i = 0; i < 2; ++i) {
      const int r = qrow0 + 32 * i;
      *(u32x4*)(Qs + r * 256 + ((qch ^ (r & 15)) << 4)) = R.q[i]; *(u32x4*)(Ks + r * 256 + ((qch ^ (r & 15)) << 4)) = R.k[i];
      const int k = trow0 + 64 * i; *(u32x4*)(KTs + k * 128 + ((tch ^ (k & 7)) << 4)) = R.t[i];
    }
    const unsigned wv[4] = {R.v.x, R.v.y, R.v.z, R.v.w};
#pragma unroll
    for (int i = 0; i < 8; ++i) {
      const int v = vt_v + i;
      *(bf16_t*)(VTs + v * 128 + (((vt_t >> 3) ^ (v & 7)) << 4) + (vt_t & 7) * 2) = (bf16_t)((wv[i >> 1] >> ((i & 1) * 16)) & 0xffffu);
    }
    if (tid < 384) VCs[tid] = R.c;
  };
  auto body = [&](const int n) {
    const int tok0 = b * 2048 + n * 64;
    {
      const int k = w * 16 + fq * 4;
      const f32x4 er = *(const f32x4*)(VCs + k);
#pragma unroll
      for (int vt = 0; vt < 4; ++vt) {
        const int v = vt * 16 + fr;
        u32x2 pk; pk.x = cvt_pk_bf16(hacc[vt][0] * er[0], hacc[vt][1] * er[1]); pk.y = cvt_pk_bf16(hacc[vt][2] * er[2], hacc[vt][3] * er[3]);
        *(u32x2*)(HTs + v * 256 + (((k >> 3) ^ (v & 15)) << 4) + (k & 7) * 2) = pk;
      }
    }
    {
      const int tt = w >> 1, st0 = (w & 1) * 2;
      f32x4 d[2] = {(f32x4){0.f, 0.f, 0.f, 0.f}, (f32x4){0.f, 0.f, 0.f, 0.f}};
#pragma unroll
      for (int ks = 0; ks < 4; ++ks) {
        const bf16x8 qf = lfrag(Qs, tt * 16 + fr, 256, ks * 4 + fq, 15);
#pragma unroll
        for (int s2 = 0; s2 < 2; ++s2) {
          const bf16x8 kf = lfrag(Ks, (st0 + s2) * 16 + fr, 256, ks * 4 + fq, 15);
          d[s2] = __builtin_amdgcn_mfma_f32_16x16x32_bf16(kf, qf, d[s2], 0, 0, 0);
        }
      }
      const int t = tt * 16 + fr;
#pragma unroll
      for (int s2 = 0; s2 < 2; ++s2) {
        const int s = (st0 + s2) * 16 + fq * 4;
        const float a0 = (s + 0 <= t) ? d[s2][0] : 0.f, a1 = (s + 1 <= t) ? d[s2][1] : 0.f, a2 = (s + 2 <= t) ? d[s2][2] : 0.f, a3 = (s + 3 <= t) ? d[s2][3] : 0.f;
        u32x2 pk; pk.x = cvt_pk_bf16(a0, a1); pk.y = cvt_pk_bf16(a2, a3);
        *(u32x2*)(ATs + t * 128 + (((s >> 3) ^ (t & 7)) << 4) + (s & 7) * 2) = pk;
      }
    }
    __syncthreads();
    {
      const int tt = w >> 1, vt0 = (w & 1) * 2;
      f32x4 o[2] = {(f32x4){0.f, 0.f, 0.f, 0.f}, (f32x4){0.f, 0.f, 0.f, 0.f}};
#pragma unroll
      for (int ks = 0; ks < 2; ++ks) {
        const bf16x8 af = lfrag(ATs, tt * 16 + fr, 128, ks * 4 + fq, 7);
#pragma unroll
        for (int v2 = 0; v2 < 2; ++v2) o[v2] = __builtin_amdgcn_mfma_f32_16x16x32_bf16(lfrag(VTs, (vt0 + v2) * 16 + fr, 128, ks * 4 + fq, 7), af, o[v2], 0, 0, 0);
      }
#pragma unroll
      for (int ks = 0; ks < 4; ++ks) {
        const bf16x8 qf = lfrag(Qs, tt * 16 + fr, 256, ks * 4 + fq, 15);
#pragma unroll
        for (int v2 = 0; v2 < 2; ++v2) o[v2] = __builtin_amdgcn_mfma_f32_16x16x32_bf16(lfrag(HTs, (vt0 + v2) * 16 + fr, 256, ks * 4 + fq, 15), qf, o[v2], 0, 0, 0);
      }
#pragma unroll
      for (int v2 = 0; v2 < 2; ++v2) {
        u32x2 pk; pk.x = cvt_pk_bf16(o[v2][0], o[v2][1]); pk.y = cvt_pk_bf16(o[v2][2], o[v2][3]);
        *(u32x2*)(p.a1 + (size_t)(tok0 + tt * 16 + fr) * 1024 + h * 256 + v0 + (vt0 + v2) * 16 + fq * 4) = pk;
      }
    }
    {
      const int k = w * 16 + fq * 4;
      const f32x4 ec = *(const f32x4*)(VCs + 128 + k), dc = *(const f32x4*)(VCs + 256 + k);
      f32x4 u[4];
#pragma unroll
      for (int vt = 0; vt < 4; ++vt) u[vt] = (f32x4){0.f, 0.f, 0.f, 0.f};
#pragma unroll
      for (int ks = 0; ks < 2; ++ks) {
        const bf16x8 kf = lfrag(KTs, w * 16 + fr, 128, ks * 4 + fq, 7);
#pragma unroll
        for (int vt = 0; vt < 4; ++vt) u[vt] = __builtin_amdgcn_mfma_f32_16x16x32_bf16(kf, lfrag(VTs, vt * 16 + fr, 128, ks * 4 + fq, 7), u[vt], 0, 0, 0);
      }
#pragma unroll
      for (int vt = 0; vt < 4; ++vt)
#pragma unroll
        for (int j = 0; j < 4; ++j) hacc[vt][j] = dc[j] * hacc[vt][j] + ec[j] * u[vt][j];
    }
  };
  GlaRegs RA, RB;
  __syncthreads();
  load_regs(0, RA);
  store_regs(RA);
  __syncthreads();
  load_regs(1, RA);
  for (int n = 0; n < 32; n += 2) {
    if (n + 2 < 32) load_regs(n + 2, RB);
    body(n);
    __syncthreads();
    store_regs(RA);
    __syncthreads();
    if (n + 3 < 32) load_regs(n + 3, RA);
    body(n + 1);
    __syncthreads();
    if (n + 2 < 32) store_regs(RB);
    __syncthreads();
  }
  float* st = p.out + OFF_GLA_P + ((size_t)(b * 4 + h) * 128) * 256;
#pragma unroll
  for (int vt = 0; vt < 4; ++vt)
#pragma unroll
    for (int j = 0; j < 4; ++j) st[(size_t)(w * 16 + fq * 4 + j) * 256 + v0 + vt * 16 + fr] = hacc[vt][j];
}

__device__ void gla_phase(const Params& p, char* smem) {
  const int sub = threadIdx.x >> 8, tid = threadIdx.x & 255;
  const int G = (int)gridDim.x;
  if (G >= 256) {
    if ((int)blockIdx.x < 128) gla_main_item(p, blockIdx.x, smem);
    else for (int base = ((int)blockIdx.x - 128) * 2; base < 512; base += (G - 128) * 2) gla_sample_item(p, base + sub, smem + sub * 65536, tid);
  } else {
    for (int item = blockIdx.x; item < 128; item += G) gla_main_item(p, item, smem);
    for (int base = blockIdx.x * 2; base < 512; base += G * 2) gla_sample_item(p, base + sub, smem + sub * 65536, tid);
  }
}

__device__ void gla_gate_rows(const Params& p) {
  const int lane = threadIdx.x & 63, wid = threadIdx.x >> 6;
  const bf16_t* proj = (const bf16_t*)p.big;
  const int nwav = gridDim.x * 8;
  f32x4 g[4];
#pragma unroll
  for (int i = 0; i < 4; ++i) g[i] = *(const f32x4*)(p.gla_g_head + i * 256 + lane * 4);
  for (int row0 = blockIdx.x * 8 + wid; row0 < T; row0 += 2 * nwav) {
    u32x2 ow[2][4], rw[2][4]; bool ok[2];
#pragma unroll
    for (int r = 0; r < 2; ++r) {
      const int row = row0 + r * nwav; ok[r] = row < T;
      if (ok[r]) {
#pragma unroll
        for (int i = 0; i < 4; ++i) { ow[r][i] = *(const u32x2*)(p.a1 + (size_t)row * 1024 + i * 256 + lane * 4); rw[r][i] = *(const u32x2*)(proj + (size_t)row * PS + 2048 + i * 256 + lane * 4); }
      }
    }
#pragma unroll
    for (int r = 0; r < 2; ++r) {
      if (!ok[r]) continue;
      const int row = row0 + r * nwav;
#pragma unroll
      for (int i = 0; i < 4; ++i) {
        const float o[4] = {bflo(ow[r][i].x), bfhi(ow[r][i].x), bflo(ow[r][i].y), bfhi(ow[r][i].y)};
        float ss = o[0] * o[0] + o[1] * o[1] + o[2] * o[2] + o[3] * o[3];
        ss = wave_sum(ss);
        const float rs = rsqrtf(ss * (1.0f / 256.0f) + EPS);
        const float rr[4] = {bflo(rw[r][i].x), bfhi(rw[r][i].x), bflo(rw[r][i].y), bfhi(rw[r][i].y)};
        float y[4];
#pragma unroll
        for (int j = 0; j < 4; ++j) y[j] = o[j] * rs * g[i][j] * (rr[j] / (1.0f + __expf(-rr[j])));
        u32x2 w; w.x = cvt_pk_bf16(y[0], y[1]); w.y = cvt_pk_bf16(y[2], y[3]);
        *(u32x2*)(p.a1 + (size_t)row * 1024 + i * 256 + lane * 4) = w;
      }
    }
  }
}

__device__ __forceinline__ bf16x8 pack8(const float* s, float sgn) {
  const f32x4 a = *(const f32x4*)s, b = *(const f32x4*)(s + 4);
  union { u32x4 u; bf16x8 v; } r;
  r.u.x = cvt_pk_bf16(a[0] * sgn, a[1] * sgn); r.u.y = cvt_pk_bf16(a[2] * sgn, a[3] * sgn);
  r.u.z = cvt_pk_bf16(b[0] * sgn, b[1] * sgn); r.u.w = cvt_pk_bf16(b[2] * sgn, b[3] * sgn);
  return r.v;
}

struct S5Consts { bf16x8 Bb[8]; bf16x8 Cc[4]; float lr, li, dsk; };

__device__ __forceinline__ void s5_load_consts(const Params& p, const int g, const int lane, S5Consts& k) {
  const int fr = lane & 15, fq = lane >> 4;
  const bf16x8 zero8 = {0, 0, 0, 0, 0, 0, 0, 0};
#pragma unroll
  for (int nt = 0; nt < 8; ++nt) {
    const int pp = nt * 8 + (fr >> 1);
    const float* src = p.bb + ((fr & 1) ? 65536 : 0) + (size_t)(g * 64 + pp) * 16 + (fq & 1) * 8;
    const bf16x8 v = pack8(src, 1.0f);
    k.Bb[nt] = (fq < 2) ? v : zero8;
  }
#pragma unroll
  for (int ks = 0; ks < 4; ++ks) {
    const int p0 = ks * 16 + fq * 4;
    const f32x4 cr = *(const f32x4*)(p.s5_c_re + (size_t)(g * 16 + fr) * 64 + p0), ci = *(const f32x4*)(p.s5_c_im + (size_t)(g * 16 + fr) * 64 + p0);
    union { u32x4 u; bf16x8 v; } r;
    r.u.x = cvt_pk_bf16(cr[0], -ci[0]); r.u.y = cvt_pk_bf16(cr[1], -ci[1]); r.u.z = cvt_pk_bf16(cr[2], -ci[2]); r.u.w = cvt_pk_bf16(cr[3], -ci[3]);
    k.Cc[ks] = r.v;
  }
  k.lr = p.lam[g * 64 + lane]; k.li = p.lam[4096 + g * 64 + lane];
  k.dsk = p.s5_d[g * 16 + fr];
}

template <bool FULL>
__device__ __forceinline__ void s5_segment(const Params& p, const S5Consts& k, const int tok0, const int L, const int g, float& hr, float& hi,
                                           char* wl, const int lane) {
  const int fr = lane & 15, fq = lane >> 4;
  float* bu_s = (float*)wl;
  bf16_t* h_s = (bf16_t*)(wl + 8448);
  bf16_t* u_s = (bf16_t*)(wl + 12800);
  const bf16_t* u = (const bf16_t*)p.big;
  const u32x4 zero4 = {0u, 0u, 0u, 0u};
  const bf16_t* ub = u + (size_t)(tok0 + fr) * 1024 + g * 16 + (fq & 1) * 8;
#define S5_LD(c) ((fq < 2 && (c) + fr < L) ? *(const u32x4*)(ub + (size_t)(c) * 1024) : zero4)
  u32x4 q0 = S5_LD(0), q1 = S5_LD(16), q2 = S5_LD(32), q3 = S5_LD(48);
  for (int c0 = 0; c0 < L; c0 += 16) {
    const u32x4 cur = q0; q0 = q1; q1 = q2; q2 = q3; q3 = S5_LD(c0 + 64);
    union { u32x4 u4; bf16x8 v; } ua; ua.u4 = cur;
#pragma unroll
    for (int nt = 0; nt < 8; ++nt) {
      const f32x4 d = __builtin_amdgcn_mfma_f32_16x16x32_bf16(ua.v, k.Bb[nt], (f32x4){0.f, 0.f, 0.f, 0.f}, 0, 0, 0);
#pragma unroll
      for (int j = 0; j < 4; ++j) bu_s[(fq * 4 + j) * 132 + nt * 16 + fr] = d[j];
    }
    if (FULL && fq < 2) *(u32x4*)(u_s + fr * 16 + fq * 8) = cur;
    lds_fence();
    const int nsteps = (L - c0) < 16 ? (L - c0) : 16;
    f32x2 bu[16];
#pragma unroll
    for (int tt = 0; tt < 16; ++tt) bu[tt] = *(const f32x2*)(bu_s + tt * 132 + 2 * lane);
#pragma unroll
    for (int tt = 0; tt < 16; ++tt) {
      if (tt < nsteps) {
        const float nr = k.lr * hr - k.li * hi + bu[tt][0];
        const float ni = k.lr * hi + k.li * hr + bu[tt][1];
        hr = nr; hi = ni;
      }
      if (FULL) ((unsigned*)h_s)[tt * 68 + lane] = cvt_pk_bf16(hr, hi);
    }
    lds_fence();
    if (FULL) {
      f32x4 y = {0.f, 0.f, 0.f, 0.f};
#pragma unroll
      for (int ks = 0; ks < 4; ++ks) {
        const bf16x8 ha = *(const bf16x8*)(h_s + fr * 136 + ks * 32 + fq * 8);
        y = __builtin_amdgcn_mfma_f32_16x16x32_bf16(ha, k.Cc[ks], y, 0, 0, 0);
      }
#pragma unroll
      for (int j = 0; j < 4; ++j) {
        const int tt = fq * 4 + j;
        if (c0 + tt < L) {
          const float yy = y[j] + k.dsk * bf2f(u_s[tt * 16 + fr]);
          const float z = yy / (1.0f + __expf(-1.5957691216057308f * (yy + 0.044715f * yy * yy * yy)));
          p.a1[(size_t)(tok0 + c0 + tt) * 1024 + g * 16 + fr] = f2bf(z);
        }
      }
      lds_fence();
    }
  }
#undef S5_LD
}

__device__ void s5_phase(const Params& p, char* smem) {
  const int tid = threadIdx.x, lane = tid & 63, wid = tid >> 6;
  char* wl = smem + wid * 14336;
  float* carry = (float*)(smem + 114688);
  for (int pb = blockIdx.x * 2; pb < 512; pb += gridDim.x * 2) {
    const int pl = wid >> 2, seg = wid & 3, pair = pb + pl;
    const int b = pair >> 6, g = pair & 63;
    const int tok0 = b * 2048 + seg * 512;
    S5Consts k; s5_load_consts(p, g, lane, k);
    float hr = 0.f, hi = 0.f;
    s5_segment<false>(p, k, tok0, 512, g, hr, hi, wl, lane);
    __syncthreads();
    carry[((pl * 4 + seg) * 2 + 0) * 64 + lane] = hr; carry[((pl * 4 + seg) * 2 + 1) * 64 + lane] = hi;
    __syncthreads();
    float pr = k.lr, pi = k.li;
#pragma unroll
    for (int i = 0; i < 9; ++i) { const float tr = pr * pr - pi * pi, ti = 2.0f * pr * pi; pr = tr; pi = ti; }
    hr = 0.f; hi = 0.f;
    for (int s2 = 0; s2 < seg; ++s2) {
      const float fr_ = carry[((pl * 4 + s2) * 2 + 0) * 64 + lane], fi_ = carry[((pl * 4 + s2) * 2 + 1) * 64 + lane];
      const float nr = pr * hr - pi * hi + fr_, ni = pr * hi + pi * hr + fi_;
      hr = nr; hi = ni;
    }
    s5_segment<true>(p, k, tok0, 512, g, hr, hi, wl, lane);
    if (seg == 3) {
      p.out[OFF_S5RP + (size_t)(b * 64 + g) * 64 + lane] = hr; p.out[OFF_S5IP + (size_t)(b * 64 + g) * 64 + lane] = hi;
    }
    __syncthreads();
  }
  const int gw = wid * gridDim.x + blockIdx.x, nw = gridDim.x * 8;
  const bool same_g = (nw & 63) == 0;
  S5Consts ks;
  if (same_g && gw < 8192) s5_load_consts(p, gw & 63, lane, ks);
  for (int it = gw; it < 8192; it += nw) {
    const int b = it >> 6, g = it & 63;
    if (!same_g) s5_load_consts(p, g, lane, ks);
    float hr = p.s5_re[(size_t)(b * 64 + g) * 64 + lane], hi = p.s5_im[(size_t)(b * 64 + g) * 64 + lane];
    s5_segment<true>(p, ks, TP + b * 4, 4, g, hr, hi, wl, lane);
    p.out[OFF_S5RS + (size_t)(b * 64 + g) * 64 + lane] = hr; p.out[OFF_S5IS + (size_t)(b * 64 + g) * 64 + lane] = hi;
  }
}

#define XB_TMO      128
#define XB_XCNT(j)  (256  + 64 * (j))
#define XB_XSUB(j)  (1280 + 64 * (j))
#define XB_XGEN(j)  (2304 + 64 * (j))
#define XB_TOP      3328
#define XB_TOPGEN   3392
#define XCD_BAR_WORDS 3456
#define XB_SPIN_CAP (1u << 18)
__device__ __forceinline__ unsigned xb_ld(unsigned* p)              { return __hip_atomic_load(p, __ATOMIC_RELAXED, __HIP_MEMORY_SCOPE_AGENT); }
__device__ __forceinline__ unsigned xb_add(unsigned* p, unsigned v) { return __hip_atomic_fetch_add(p, v, __ATOMIC_RELAXED, __HIP_MEMORY_SCOPE_AGENT); }
__device__ __forceinline__ unsigned xb_xcc_id() { return (unsigned)__builtin_amdgcn_s_getreg((3 << 11) | 20) & 0xFu; }
#define XB_SPIN(cond, bar) do { unsigned _sp = 0; while (cond) { __builtin_amdgcn_s_sleep(1); \
    if ((++_sp & 255u) == 0u) { if (xb_ld(&(bar)[XB_TMO])) break; if (_sp > XB_SPIN_CAP) { atomicAdd(&(bar)[XB_TMO], 1u); break; } } } } while (0)
struct XcdBarrier { unsigned* bar; unsigned x; volatile LAS unsigned* st; };
__device__ __forceinline__ XcdBarrier xcd_barrier_post(unsigned* bar, volatile LAS unsigned* st) {
  XcdBarrier b; b.bar = bar; b.x = xb_xcc_id(); b.st = st;
  if (threadIdx.x == 0) (void)xb_add(&bar[XB_XCNT(b.x)], 1u);
  return b;
}
__device__ __forceinline__ void xcd_barrier_complete(unsigned* bar, unsigned x, unsigned& nloc, unsigned& nx) {
  const unsigned G = gridDim.x * gridDim.y * gridDim.z;
  unsigned sum, cnt, mine, sp = 0u;
  for (;;) {
    sum = 0u; cnt = 0u; mine = 0u;
#pragma unroll
    for (unsigned j = 0; j < 16; ++j) { const unsigned c = xb_ld(&bar[XB_XCNT(j)]); sum += c; cnt += (c > 0u) ? 1u : 0u; mine = (j == x) ? c : mine; }
    if (sum == G) break;
    __builtin_amdgcn_s_sleep(1);
    if ((++sp & 255u) == 0u) { if (xb_ld(&bar[XB_TMO])) break; if (sp > XB_SPIN_CAP) { atomicAdd(&bar[XB_TMO], 1u); break; } }
  }
  nloc = mine > 0u ? mine : 1u; nx = cnt > 0u ? cnt : 1u;
}
__device__ __forceinline__ void xcd_barrier(const XcdBarrier& b) {
  asm volatile("s_waitcnt vmcnt(0)" ::: "memory");
  __syncthreads();
  if (threadIdx.x == 0) {
    unsigned* bar = b.bar;
    __builtin_amdgcn_s_waitcnt(0);
    unsigned nloc = b.st[0], nx = b.st[1];
    if (nloc == 0u) { xcd_barrier_complete(bar, b.x, nloc, nx); b.st[0] = nloc; b.st[1] = nx; }
    const unsigned old = xb_add(&bar[XB_XSUB(b.x)], 1u);
    const unsigned gen = old / nloc;
    if (old + 1u == (gen + 1u) * nloc) {
      __builtin_amdgcn_fence(__ATOMIC_RELEASE, "agent");
      asm volatile("s_waitcnt vmcnt(0)" ::: "memory");
      const unsigned og = xb_add(&bar[XB_TOP], 1u);
      const unsigned tg = og / nx;
      if (og + 1u == (tg + 1u) * nx) xb_add(&bar[XB_TOPGEN], 1u);
      else XB_SPIN(xb_ld(&bar[XB_TOPGEN]) == tg, bar);
      __builtin_amdgcn_fence(__ATOMIC_ACQUIRE, "agent");
      xb_add(&bar[XB_XGEN(b.x)], 1u);
      asm volatile("s_waitcnt vmcnt(0)" ::: "memory");
    } else {
      XB_SPIN(xb_ld(&bar[XB_XGEN(b.x)]) == gen, bar);
      __builtin_amdgcn_fence(__ATOMIC_ACQUIRE, "agent");
      asm volatile("s_waitcnt vmcnt(0)" ::: "memory");
    }
  }
  __syncthreads();
}
#define grid_sync() xcd_barrier(xbar)

#ifndef DOUBLE_MASK
#define DOUBLE_MASK 0
#endif
#define PHASE(k, call) \
  if (p.phase_lo <= (k) && (k) < p.phase_hi) { if ((DOUBLE_MASK >> (k)) & 1) { call; grid_sync(); } call; if ((k) + 1 < p.phase_hi) grid_sync(); }

#define STAGGER(main_call, sample_call) \
  [&]() { if (blockIdx.x & 1) { sample_call; main_call; } else { main_call; sample_call; } }()

__global__ void __launch_bounds__(512, 2) mega_kernel(Params p) {
  extern __shared__ __attribute__((aligned(16))) char smem[];
  LAS unsigned char* lds = (LAS unsigned char*)smem;
  volatile LAS unsigned* xst = (volatile LAS unsigned*)(lds + 131072);
  if (threadIdx.x < 4) xst[threadIdx.x] = 0u;
  __syncthreads();
  const XcdBarrier xbar = xcd_barrier_post(p.bar, xst);
  if (p.phase_lo == 12345) cg::this_grid().sync();
  PHASE(0, (transpose_tiles(p, smem), s5_consts(p), norm0_rows(p)))
  PHASE(1, (gemm_phase<0>(lds, p.a1, p.wt_gla_in, TP, PS, 1024, p.big, PS), sgemm_sample<0, 1024>(p.a1, p.wt_gla_in, PS, p.big, PS, smem, (gridDim.x == 256) ? 64 : 0)))
  PHASE(2, (gla_prep(p, smem), __syncthreads()))
  PHASE(3, gla_phase(p, smem))
  PHASE(4, gla_gate_rows(p))
  PHASE(5, (gemm_phase<0>(lds, p.a1, p.wt_gla_out, TP, 1024, 1024, p.big, 1024), sgemm_sample<0, 1024>(p.a1, p.wt_gla_out, 1024, p.big, 1024, smem)))
  PHASE(6, rows_update(p, (const bf16_t*)p.big, p.g_post_mix, p.g_pre_mlp))
  PHASE(7, STAGGER((gemm_phase<1>(lds, p.a1, p.wt_up, TP, 4096, 1024, p.big, 4096)), (sgemm_sample<1, 1024, 4>(p.a1, p.wt_up, 4096, p.big, 4096, smem))))
  PHASE(8, (gemm_phase<0>(lds, (const bf16_t*)p.big, p.wt_down, TP, 1024, 4096, p.a1, 1024), sgemm_sample<0, 4096>((const bf16_t*)p.big, p.wt_down, 1024, p.a1, 1024, smem)))
  PHASE(9, rows_update(p, p.a1, p.g_post_mlp, p.g_pre_mix + 1024))
  PHASE(10, (gemm_phase<0>(lds, p.a1, p.wt_s5_in, TP, 1024, 1024, p.big, 1024), sgemm_sample<0, 1024>(p.a1, p.wt_s5_in, 1024, p.big, 1024, smem)))
  PHASE(11, s5_phase(p, smem))
  PHASE(12, STAGGER((gemm_phase<3>(lds, p.a1, p.wt_glu, TP, 2048, 1024, p.big, 1024)), (sgemm_sample<3, 1024, 4>(p.a1, p.wt_glu, 2048, p.big, 1024, smem))))
  PHASE(13, rows_update(p, (const bf16_t*)p.big, p.g_post_mix + 1024, p.g_pre_mlp + 1024))
  PHASE(14, STAGGER((gemm_phase<1>(lds, p.a1, p.wt_up + (size_t)4096 * 1024, TP, 4096, 1024, p.big, 4096)), (sgemm_sample<1, 1024, 4>(p.a1, p.wt_up + (size_t)4096 * 1024, 4096, p.big, 4096, smem))))
  PHASE(15, (gemm_phase<0>(lds, (const bf16_t*)p.big, p.wt_down + (size_t)4096 * 1024, TP, 1024, 4096, p.a1, 1024), sgemm_sample<0, 4096>((const bf16_t*)p.big, p.wt_down + (size_t)4096 * 1024, 1024, p.a1, 1024, smem)))
  PHASE(16, rows_update(p, p.a1, p.g_post_mlp + 1024, nullptr))
}

extern "C" void kernel_launch(void* const* d_in, const int* in_sizes, int n_in, void* d_out, int out_size, void* d_ws,
                              size_t ws_size, hipStream_t stream) {
  (void)in_sizes; (void)n_in; (void)out_size; (void)ws_size;
  Params p{};
  p.x_prompt = (const float*)d_in[0]; p.x_sample = (const float*)d_in[1]; p.state_gla = (const float*)d_in[2];
  p.s5_re = (const float*)d_in[3]; p.s5_im = (const float*)d_in[4];
  p.g_pre_mix = (const float*)d_in[5]; p.g_post_mix = (const float*)d_in[6]; p.g_pre_mlp = (const float*)d_in[7]; p.g_post_mlp = (const float*)d_in[8];
  p.w_up = (const float*)d_in[9]; p.w_down = (const float*)d_in[10]; p.gla_w_in = (const float*)d_in[11];
  p.gla_w_gate_up = (const float*)d_in[12]; p.gla_b_gate = (const float*)d_in[13]; p.gla_g_head = (const float*)d_in[14]; p.gla_w_out = (const float*)d_in[15];
  p.s5_w_in = (const float*)d_in[16]; p.s5_a_re = (const float*)d_in[17]; p.s5_a_im = (const float*)d_in[18]; p.s5_log_step = (const float*)d_in[19];
  p.s5_b_re = (const float*)d_in[20]; p.s5_b_im = (const float*)d_in[21]; p.s5_c_re = (const float*)d_in[22]; p.s5_c_im = (const float*)d_in[23];
  p.s5_d = (const float*)d_in[24]; p.s5_glu_a = (const float*)d_in[25]; p.s5_glu_b = (const float*)d_in[26];
  p.out = (float*)d_out;
  char* ws = (char*)d_ws;
  p.wt_gla_in = (bf16_t*)(ws + 0);
  p.wt_gla_out = (bf16_t*)(ws + 6815744);
  p.wt_up = (bf16_t*)(ws + 8912896);
  p.wt_down = (bf16_t*)(ws + 25690112);
  p.wt_s5_in = (bf16_t*)(ws + 42467328);
  p.wt_glu = (bf16_t*)(ws + 44564480);
  p.lam = (float*)(ws + 48758784);
  p.bb = (float*)(ws + 48791552);
  p.a1 = (bf16_t*)(ws + 49315840);
  p.big = ws + 83918848;
  p.bar = (unsigned*)(ws + 222330880);
  p.xr = (bf16_t*)(ws + 222344704);

  static int grid_blocks = 0;
  if (!grid_blocks) {
    int dev = 0, cus = 0, per_cu = 0;
    (void)hipGetDevice(&dev);
    (void)hipDeviceGetAttribute(&cus, hipDeviceAttributeMultiprocessorCount, dev);
    (void)hipFuncSetAttribute((const void*)mega_kernel, hipFuncAttributeMaxDynamicSharedMemorySize, LDS_BYTES);
    (void)hipOccupancyMaxActiveBlocksPerMultiprocessor(&per_cu, mega_kernel, 512, LDS_BYTES);
    if (per_cu > 1) per_cu = 1;
    if (per_cu < 1) per_cu = 1;
    if (cus <= 0) cus = 256;
    grid_blocks = cus * per_cu;
  }
#if ONE_LAUNCH
  p.phase_lo = 0; p.phase_hi = NPHASE;
  (void)hipMemsetAsync(p.bar, 0, XCD_BAR_WORDS * 4, stream);
  void* args[] = {&p};
  hipError_t e = hipLaunchCooperativeKernel((void*)mega_kernel, dim3(grid_blocks), dim3(512), args, LDS_BYTES, stream);
  if (e != hipSuccess) fprintf(stderr, "cooperative launch failed: %s (grid %d)\n", hipGetErrorString(e), grid_blocks);
#endif
}
```

```cpp
#include <hip/hip_runtime.h>
#include <hip/hip_cooperative_groups.h>
#include <cstdio>
namespace cg = cooperative_groups;

#ifndef ONE_LAUNCH
#define ONE_LAUNCH 1
#endif

typedef unsigned short bf16_t;
typedef short bf16x8 __attribute__((ext_vector_type(8)));
typedef float f32x4 __attribute__((ext_vector_type(4)));
typedef unsigned u32x4 __attribute__((ext_vector_type(4)));
typedef unsigned u32x2 __attribute__((ext_vector_type(2)));

constexpr int TP = 16384;
constexpr int T = 16896;
constexpr int PS = 3328;
#define LAS __attribute__((address_space(3)))
constexpr int LDS_BYTES = 131072 + 16;
constexpr float EPS = 1e-6f;
constexpr int NPHASE = 17;

constexpr size_t OFF_Y = 0;
constexpr size_t OFF_GLA_P = 17301504;
constexpr size_t OFF_GLA_S = 18350080;
constexpr size_t OFF_S5RP = 35127296;
constexpr size_t OFF_S5IP = 35160064;
constexpr size_t OFF_S5RS = 35192832;
constexpr size_t OFF_S5IS = 35717120;

struct Params {
  const float *x_prompt, *x_sample, *state_gla, *s5_re, *s5_im;
  const float *g_pre_mix, *g_post_mix, *g_pre_mlp, *g_post_mlp;
  const float *w_up, *w_down, *gla_w_in, *gla_w_gate_up, *gla_b_gate, *gla_g_head, *gla_w_out;
  const float *s5_w_in, *s5_a_re, *s5_a_im, *s5_log_step, *s5_b_re, *s5_b_im, *s5_c_re, *s5_c_im, *s5_d, *s5_glu_a, *s5_glu_b;
  float* out;
  bf16_t *wt_gla_in, *wt_gla_out, *wt_up, *wt_down, *wt_s5_in, *wt_glu;
  float *lam, *bb;
  bf16_t* a1;
  char* big;
  unsigned* bar;
  bf16_t* xr;
  int phase_lo, phase_hi;
};

typedef float f32x2 __attribute__((ext_vector_type(2)));
typedef __bf16 bf16x2_t __attribute__((ext_vector_type(2)));
__device__ __forceinline__ unsigned cvt_pk_bf16(float lo, float hi) {
  const f32x2 v = {lo, hi};
  const bf16x2_t b = __builtin_convertvector(v, bf16x2_t);
  return __builtin_bit_cast(unsigned, b);
}
__device__ __forceinline__ float bf2f(bf16_t v) { return __uint_as_float(((unsigned)v) << 16); }
__device__ __forceinline__ float bflo(unsigned w) { return __uint_as_float(w << 16); }
__device__ __forceinline__ float bfhi(unsigned w) { return __uint_as_float(w & 0xffff0000u); }
__device__ __forceinline__ bf16_t f2bf(float f) { return (bf16_t)(cvt_pk_bf16(f, 0.f) & 0xffffu); }

__device__ __forceinline__ float wave_sum(float v) {
  v += __shfl_xor(v, 32); v += __shfl_xor(v, 16); v += __shfl_xor(v, 8);
  v += __shfl_xor(v, 4);  v += __shfl_xor(v, 2);  v += __shfl_xor(v, 1);
  return v;
}
__device__ __forceinline__ void lds_fence() { asm volatile("s_waitcnt lgkmcnt(0)" ::: "memory"); }

__device__ void transpose_tiles(const Params& p, char* smem) {
  const int sub = threadIdx.x >> 8, tid = threadIdx.x & 255;
  float* ts = (float*)(smem + sub * 32768);
  for (int base = blockIdx.x * 2; base < 5952; base += gridDim.x * 2) {
    int t = base + sub; const float* src; int ld, K, nvalid; bf16_t* dst; int glu = 0;
    if (t < 832) { src = p.gla_w_in; ld = 3088; K = 1024; nvalid = 3088; dst = p.wt_gla_in; }
    else if ((t -= 832) < 256) { src = p.gla_w_out; ld = 1024; K = 1024; nvalid = 1024; dst = p.wt_gla_out; }
    else if ((t -= 256) < 2048) { int l = t >> 10; t &= 1023; src = p.w_up + (size_t)l * 1024 * 4096; ld = 4096; K = 1024; nvalid = 4096; dst = p.wt_up + (size_t)l * 4096 * 1024; }
    else if ((t -= 2048) < 2048) { int l = t >> 10; t &= 1023; src = p.w_down + (size_t)l * 4096 * 1024; ld = 1024; K = 4096; nvalid = 1024; dst = p.wt_down + (size_t)l * 1024 * 4096; }
    else if ((t -= 2048) < 256) { src = p.s5_w_in; ld = 1024; K = 1024; nvalid = 1024; dst = p.wt_s5_in; }
    else { t -= 256; src = p.s5_glu_a; ld = 1024; K = 1024; nvalid = 2048; dst = p.wt_glu; glu = 1; }
    const int ktiles = K >> 6;
    const int nt = t / ktiles, kt = t - nt * ktiles;
    const int n0 = nt * 64, k0 = kt * 64;
    const int nl = tid & 63, kl = tid >> 6;
    const int n = n0 + nl;
    const float* cp = nullptr;
    if (glu) {
      const int col = (n >> 5) * 16 + (n & 15);
      cp = (((n >> 4) & 1) ? p.s5_glu_b : p.s5_glu_a) + col;
    } else if (n < nvalid) cp = src + n;
    __syncthreads();
float tv[16];
#pragma unroll
    for (int i = 0; i < 16; ++i) tv[i] = cp ? cp[(size_t)(k0 + kl + 4 * i) * ld] : 0.f;
#pragma unroll
    for (int i = 0; i < 16; ++i) ts[(kl + 4 * i) * 65 + nl] = tv[i];
    __syncthreads();
    const int k8 = (tid & 7) * 8;
#pragma unroll
    for (int i = 0; i < 2; ++i) {
      const int nn = (tid >> 3) + 32 * i;
      u32x4 w;
      w.x = cvt_pk_bf16(ts[(k8 + 0) * 65 + nn], ts[(k8 + 1) * 65 + nn]);
      w.y = cvt_pk_bf16(ts[(k8 + 2) * 65 + nn], ts[(k8 + 3) * 65 + nn]);
      w.z = cvt_pk_bf16(ts[(k8 + 4) * 65 + nn], ts[(k8 + 5) * 65 + nn]);
      w.w = cvt_pk_bf16(ts[(k8 + 6) * 65 + nn], ts[(k8 + 7) * 65 + nn]);
      *(u32x4*)(dst + (size_t)(n0 + nn) * K + k0 + k8) = w;
    }
  }
}

__device__ void s5_consts(const Params& p) {
  for (int i = blockIdx.x * 512 + threadIdx.x; i < 4096; i += gridDim.x * 512) {
    const int g = i >> 6;
    const float ar = p.s5_a_re[i], ai = p.s5_a_im[i];
    const float dt = expf(p.s5_log_step[g]);
    const float mag = expf(ar * dt);
    const float lr = mag * cosf(ai * dt), li = mag * sinf(ai * dt);
    const float nr = lr - 1.0f, ni = li;
    const float den = ar * ar + ai * ai;
    const float zr = (nr * ar + ni * ai) / den;
    const float zi = (ni * ar - nr * ai) / den;
    p.lam[i] = lr; p.lam[4096 + i] = li;
#pragma unroll
    for (int c = 0; c < 16; ++c) {
      const float br = p.s5_b_re[i * 16 + c], bi = p.s5_b_im[i * 16 + c];
      p.bb[i * 16 + c] = zr * br - zi * bi;
      p.bb[65536 + i * 16 + c] = zr * bi + zi * br;
    }
  }
}

__device__ void norm0_rows(const Params& p) {
  const int lane = threadIdx.x & 63, wid = threadIdx.x >> 6;
  for (int row = blockIdx.x * 8 + wid; row < T; row += gridDim.x * 8) {
    const float* xr = (row < TP) ? p.x_prompt + (size_t)row * 1024 : p.x_sample + (size_t)(row - TP) * 1024;
    f32x4 v[4]; float ss = 0.f;
#pragma unroll
    for (int i = 0; i < 4; ++i) { v[i] = *(const f32x4*)(xr + i * 256 + lane * 4); ss += v[i][0] * v[i][0] + v[i][1] * v[i][1] + v[i][2] * v[i][2] + v[i][3] * v[i][3]; }
    ss = wave_sum(ss);
    const float r = rsqrtf(ss * (1.0f / 1024.0f) + EPS);
#pragma unroll
    for (int i = 0; i < 4; ++i) {
      const f32x4 g = *(const f32x4*)(p.g_pre_mix + i * 256 + lane * 4);
      u32x2 w; w.x = cvt_pk_bf16(v[i][0] * r * g[0], v[i][1] * r * g[1]); w.y = cvt_pk_bf16(v[i][2] * r * g[2], v[i][3] * r * g[3]);
      *(u32x2*)(p.a1 + (size_t)row * 1024 + i * 256 + lane * 4) = w;
      u32x2 xw; xw.x = cvt_pk_bf16(v[i][0], v[i][1]); xw.y = cvt_pk_bf16(v[i][2], v[i][3]);
      *(u32x2*)(p.xr + (size_t)row * 1024 + i * 256 + lane * 4) = xw;
    }
  }
}

__device__ void rows_update(const Params& p, const bf16_t* msrc, const float* gpost, const float* gnext) {
  const int lane = threadIdx.x & 63, wid = threadIdx.x >> 6;
  const int nwav = gridDim.x * 8;
  f32x4 gp[4], gn[4];
#pragma unroll
  for (int i = 0; i < 4; ++i) {
    gp[i] = *(const f32x4*)(gpost + i * 256 + lane * 4);
    gn[i] = gnext ? *(const f32x4*)(gnext + i * 256 + lane * 4) : (f32x4){0.f, 0.f, 0.f, 0.f};
  }
  for (int row0 = blockIdx.x * 8 + wid; row0 < T; row0 += 2 * nwav) {
    u32x2 mw[2][4], xw[2][4]; bool ok[2];
#pragma unroll
    for (int r = 0; r < 2; ++r) {
      const int row = row0 + r * nwav; ok[r] = row < T;
      if (ok[r]) {
#pragma unroll
        for (int i = 0; i < 4; ++i) { mw[r][i] = *(const u32x2*)(msrc + (size_t)row * 1024 + i * 256 + lane * 4); xw[r][i] = *(const u32x2*)(p.xr + (size_t)row * 1024 + i * 256 + lane * 4); }
      }
    }
#pragma unroll
    for (int r = 0; r < 2; ++r) {
      if (!ok[r]) continue;
      const int row = row0 + r * nwav;
      f32x4 m[4]; float ss = 0.f;
#pragma unroll
      for (int i = 0; i < 4; ++i) {
        m[i][0] = bflo(mw[r][i].x); m[i][1] = bfhi(mw[r][i].x); m[i][2] = bflo(mw[r][i].y); m[i][3] = bfhi(mw[r][i].y);
        ss += m[i][0] * m[i][0] + m[i][1] * m[i][1] + m[i][2] * m[i][2] + m[i][3] * m[i][3];
      }
      ss = wave_sum(ss);
      const float rs = rsqrtf(ss * (1.0f / 1024.0f) + EPS);
      float ss2 = 0.f;
#pragma unroll
      for (int i = 0; i < 4; ++i) {
        const float x0 = bflo(xw[r][i].x), x1 = bfhi(xw[r][i].x), x2 = bflo(xw[r][i].y), x3 = bfhi(xw[r][i].y);
        m[i][0] = x0 + m[i][0] * rs * gp[i][0]; m[i][1] = x1 + m[i][1] * rs * gp[i][1];
        m[i][2] = x2 + m[i][2] * rs * gp[i][2]; m[i][3] = x3 + m[i][3] * rs * gp[i][3];
        ss2 += m[i][0] * m[i][0] + m[i][1] * m[i][1] + m[i][2] * m[i][2] + m[i][3] * m[i][3];
        if (gnext) {
          u32x2 w; w.x = cvt_pk_bf16(m[i][0], m[i][1]); w.y = cvt_pk_bf16(m[i][2], m[i][3]);
          *(u32x2*)(p.xr + (size_t)row * 1024 + i * 256 + lane * 4) = w;
        } else {
          *(f32x4*)(p.out + OFF_Y + (size_t)row * 1024 + i * 256 + lane * 4) = m[i];
        }
      }
      if (gnext) {
        ss2 = wave_sum(ss2);
        const float r2 = rsqrtf(ss2 * (1.0f / 1024.0f) + EPS);
#pragma unroll
        for (int i = 0; i < 4; ++i) {
          u32x2 w; w.x = cvt_pk_bf16(m[i][0] * r2 * gn[i][0], m[i][1] * r2 * gn[i][1]); w.y = cvt_pk_bf16(m[i][2] * r2 * gn[i][2], m[i][3] * r2 * gn[i][3]);
          *(u32x2*)(p.a1 + (size_t)row * 1024 + i * 256 + lane * 4) = w;
        }
      }
    }
  }
}

constexpr int G_BM = 256, G_BK = 64, G_HALF = 128, G_HTB = G_HALF * G_BK * 2;
__device__ __forceinline__ int g_lds_byte(int r, int c) { const int st = (r >> 4) * 2 + (c >> 5), rr = r & 15, cc = c & 31, ob = rr * 64 + cc * 2; return st * 1024 + (ob ^ (((ob >> 9) & 1) << 5)); }
__device__ __forceinline__ void g_stage_rc(int b, int& R, int& C) { const int st = b / 1024, sb = b % 1024, swz = sb ^ (((sb >> 9) & 1) << 5); R = (st >> 1) * 16 + swz / 64; C = (st & 1) * 32 + (swz % 64) / 2; }
struct Unit { int pm, pn; };
__device__ __forceinline__ bool g_next(int i, int nM, int nN, int nwg, int G, int c, Unit& u) {
  const long L = (long)i * G + c; if (L >= nwg) return false;
  int wgid = (int)L; { const int q = nwg / 8, r = nwg % 8, xcd = wgid % 8, off = wgid / 8; wgid = (xcd < r ? xcd * (q + 1) : r * (q + 1) + (xcd - r) * q) + off; }
  const int nig = 8 * nN, gid = wgid / nig, fm = gid * 8, gsz = (nM - fm) < 8 ? (nM - fm) : 8;
  u.pm = fm + ((wgid % nig) % gsz); u.pn = (wgid % nig) / gsz; return true;
}

template <int EPI>
__device__ __forceinline__ void gemm_epilogue(const f32x4 (&acc)[2][2][4][2], const Unit& u, int wr, int wc, int fr, int fq, void* outp, int ldo) {
  const int row0 = u.pm * G_BM + wr * 64 + fr;
#pragma unroll
  for (int ai = 0; ai < 2; ++ai)
#pragma unroll
    for (int m = 0; m < 4; ++m) {
      const size_t row = (size_t)(row0 + ai * G_HALF + m * 16);
#pragma unroll
      for (int bj = 0; bj < 2; ++bj) {
        if (EPI == 3) {
          const int col = u.pn * 128 + bj * 64 + wc * 16 + 4 * fq;
          const f32x4 a = acc[ai][bj][m][0], b = acc[ai][bj][m][1]; f32x4 o;
#pragma unroll
          for (int j = 0; j < 4; ++j) o[j] = a[j] / (1.0f + __expf(-b[j]));
          u32x2 w; w.x = cvt_pk_bf16(o[0], o[1]); w.y = cvt_pk_bf16(o[2], o[3]);
          *(u32x2*)((bf16_t*)outp + row * ldo + col) = w;
        } else if (EPI == 2) {
#pragma unroll
          for (int n = 0; n < 2; ++n) {
            const int col = u.pn * G_BM + wc * 32 + 4 * fq + bj * G_HALF + n * 16;
            *(f32x4*)((float*)outp + row * ldo + col) = acc[ai][bj][m][n];
          }
        } else {
          const int col = u.pn * G_BM + wc * 32 + 8 * fq + bj * G_HALF;
          f32x4 v0 = acc[ai][bj][m][0], v1 = acc[ai][bj][m][1];
          if (EPI == 1) {
#pragma unroll
            for (int j = 0; j < 4; ++j) { const float t0 = fmaxf(v0[j], 0.f), t1 = fmaxf(v1[j], 0.f); v0[j] = t0 * t0; v1[j] = t1 * t1; }
          }
          u32x4 w; w.x = cvt_pk_bf16(v0[0], v0[1]); w.y = cvt_pk_bf16(v0[2], v0[3]); w.z = cvt_pk_bf16(v1[0], v1[1]); w.w = cvt_pk_bf16(v1[2], v1[3]);
          *(u32x4*)((bf16_t*)outp + row * ldo + col) = w;
        }
      }
    }
}

template <int EPI>
__device__ __forceinline__ void gemm_phase(LAS unsigned char* lds, const bf16_t* gA, const bf16_t* gBt, const int M, const int N, const int K, void* outp, const int ldo) {
  const int tid = threadIdx.x, wid = __builtin_amdgcn_readfirstlane(tid >> 6), lane = tid & 63, wr = wid >> 2, wc = wid & 3, fr = lane & 15, fq = lane >> 4;
  const int nt = K / G_BK;
  const int nM = M / G_BM, nN = N / G_BM, nwg = nM * nN, G = (int)gridDim.x, c = (int)blockIdx.x;
  constexpr bool PERM = (EPI == 0 || EPI == 1);
  unsigned voffA[2], voffB[2];
#pragma unroll
  for (int i = 0; i < 2; ++i) { int R, C; g_stage_rc(tid * 16 + i * 8192, R, C);
    int Rb = R; if (PERM) { const int rho = R & 31, nn = rho >> 4, ii = rho & 15; Rb = (R & ~31) + 8 * (ii >> 2) + 4 * nn + (ii & 3); }
    voffA[i] = (unsigned)(R * K + C) * 2u; voffB[i] = (unsigned)(Rb * K + C) * 2u; }
  const size_t kstep = (size_t)(G_BK * 2);
  const size_t hstep = (size_t)G_HALF * K * 2;
  const size_t tstep = 2 * hstep;
  const unsigned ldsw = (unsigned)wid * 1024u;
  const int aoff = g_lds_byte(wr * 64 + fr, fq * 8), boff = g_lds_byte(wc * 32 + fr, fq * 8);
#define PG8_SA(b, h) (((b) * 2 + (h)) * G_HTB)
#define PG8_SB(b, h) ((4 + (b) * 2 + (h)) * G_HTB)
#define PG8_STAGEX(bufoff, gbase, voff) do { _Pragma("unroll") for (int _i = 0; _i < 2; ++_i) \
    __builtin_amdgcn_global_load_lds((const unsigned*)((const char*)(gbase) + (voff)[_i]), (LAS unsigned*)(lds + (bufoff) + ldsw + _i * 8192), 16, 0, 0); } while (0)
#define PG8_LDA(dst, b, h) do { _Pragma("unroll") for (int m = 0; m < 4; ++m) _Pragma("unroll") for (int k = 0; k < 2; ++k) dst[m][k] = *(const LAS bf16x8*)(lds + PG8_SA(b, h) + aoff + m * 2048 + k * 1024); } while (0)
#define PG8_LDB(dst, b, h) do { _Pragma("unroll") for (int n = 0; n < 2; ++n) _Pragma("unroll") for (int k = 0; k < 2; ++k) dst[n][k] = *(const LAS bf16x8*)(lds + PG8_SB(b, h) + boff + n * 2048 + k * 1024); } while (0)
#define PG8_MMA(ai, bj, At, Bt) do { __builtin_amdgcn_s_setprio(1); _Pragma("unroll") for (int m = 0; m < 4; ++m) _Pragma("unroll") for (int n = 0; n < 2; ++n) _Pragma("unroll") for (int k = 0; k < 2; ++k) \
    acc[ai][bj][m][n] = __builtin_amdgcn_mfma_f32_16x16x32_bf16(Bt[n][k], At[m][k], acc[ai][bj][m][n], 0, 0, 0); __builtin_amdgcn_s_setprio(0); } while (0)
#define PG8_WAIT_V(n) asm volatile("s_waitcnt vmcnt(" #n ")" ::: "memory")
#define PG8_WAIT_L(n) asm volatile("s_waitcnt lgkmcnt(" #n ")" ::: "memory")
#define PG8_BAR __builtin_amdgcn_s_barrier()
#define PG8_SCHED __builtin_amdgcn_sched_barrier(0)
  Unit cur, nxt; int ui = 0;
  if (!g_next(0, nM, nN, nwg, G, c, cur)) return;
  f32x4 acc[2][2][4][2];
#pragma unroll
  for (int a = 0; a < 2; ++a)
#pragma unroll
    for (int b = 0; b < 2; ++b)
#pragma unroll
      for (int m = 0; m < 4; ++m)
#pragma unroll
        for (int n = 0; n < 2; ++n) acc[a][b][m][n] = (f32x4){0.f, 0.f, 0.f, 0.f};
  bf16x8 At[4][2], B0[2][2], B1[2][2];
  const char* cA = (const char*)gA + (size_t)cur.pm * tstep; const char* cB = (const char*)gBt + (size_t)cur.pn * tstep;
  PG8_STAGEX(PG8_SB(0, 0), cB, voffB); PG8_STAGEX(PG8_SA(0, 0), cA, voffA); PG8_STAGEX(PG8_SB(0, 1), cB + hstep, voffB); PG8_STAGEX(PG8_SA(0, 1), cA + hstep, voffA);
  if (wr == 1) PG8_BAR;
  PG8_WAIT_V(4); PG8_BAR;
  PG8_STAGEX(PG8_SB(1, 0), cB + kstep, voffB); PG8_STAGEX(PG8_SA(1, 0), cA + kstep, voffA); PG8_STAGEX(PG8_SB(1, 1), cB + hstep + kstep, voffB);
  PG8_WAIT_V(6); PG8_BAR;
  for (;;) {
    const bool has_next = g_next(ui + 1, nM, nN, nwg, G, c, nxt);
    const char* nA = has_next ? (const char*)gA + (size_t)nxt.pm * tstep : cA; const char* nB = has_next ? (const char*)gBt + (size_t)nxt.pn * tstep : cB;
    for (int t = 0; t < nt; t += 2) {
      const bool last = (t == nt - 2);
      const char* a1 = cA + (size_t)(t + 1) * kstep;
      const char* a2 = last ? nA : cA + (size_t)(t + 2) * kstep; const char* b2 = last ? nB : cB + (size_t)(t + 2) * kstep;
      const char* a3 = a2 + kstep; const char* b3 = b2 + kstep;
      PG8_LDB(B0, 0, 0); PG8_SCHED; PG8_LDA(At, 0, 0); PG8_STAGEX(PG8_SA(1, 1), a1 + hstep, voffA);
      PG8_WAIT_L(8); PG8_BAR; PG8_WAIT_L(0); PG8_MMA(0, 0, At, B0); PG8_BAR; PG8_SCHED;
      PG8_LDB(B1, 0, 1); PG8_STAGEX(PG8_SB(0, 0), b2, voffB);
      PG8_BAR; PG8_WAIT_L(0); PG8_MMA(0, 1, At, B1); PG8_BAR;
      PG8_LDA(At, 0, 1); PG8_STAGEX(PG8_SA(0, 0), a2, voffA);
      PG8_BAR; PG8_WAIT_L(0); PG8_MMA(1, 0, At, B0); PG8_BAR; PG8_SCHED;
      PG8_STAGEX(PG8_SB(0, 1), b2 + hstep, voffB);
      PG8_WAIT_V(6); PG8_BAR; PG8_MMA(1, 1, At, B1); PG8_BAR;
      PG8_LDB(B0, 1, 0); PG8_SCHED; PG8_LDA(At, 1, 0); PG8_STAGEX(PG8_SA(0, 1), a2 + hstep, voffA);
      PG8_WAIT_L(8); PG8_BAR; PG8_WAIT_L(0); PG8_MMA(0, 0, At, B0); PG8_BAR; PG8_SCHED;
      PG8_LDB(B1, 1, 1); PG8_STAGEX(PG8_SB(1, 0), b3, voffB);
      PG8_BAR; PG8_WAIT_L(0); PG8_MMA(0, 1, At, B1); PG8_BAR;
      PG8_LDA(At, 1, 1); PG8_STAGEX(PG8_SA(1, 0), a3, voffA);
      PG8_BAR; PG8_WAIT_L(0); PG8_MMA(1, 0, At, B0); PG8_BAR; PG8_SCHED;
      PG8_STAGEX(PG8_SB(1, 1), b3 + hstep, voffB);
      PG8_WAIT_V(6); PG8_BAR; PG8_MMA(1, 1, At, B1); PG8_BAR;
    }
    gemm_epilogue<EPI>(acc, cur, wr, wc, fr, fq, outp, ldo);
    if (!has_next) break;
#pragma unroll
    for (int a = 0; a < 2; ++a)
#pragma unroll
      for (int b = 0; b < 2; ++b)
#pragma unroll
        for (int m = 0; m < 4; ++m)
#pragma unroll
          for (int n = 0; n < 2; ++n) acc[a][b][m][n] = (f32x4){0.f, 0.f, 0.f, 0.f};
    cur = nxt; cA = nA; cB = nB; ++ui;
  }
  PG8_WAIT_V(0);
  if (wr == 0) PG8_BAR;
  PG8_BAR;
#undef PG8_SA
#undef PG8_SB
#undef PG8_STAGEX
#undef PG8_LDA
#undef PG8_LDB
#undef PG8_MMA
#undef PG8_WAIT_V
#undef PG8_WAIT_L
#undef PG8_BAR
#undef PG8_SCHED
}

template <int EPI, int K, int NF = 2>
__device__ void sgemm_sample(const bf16_t* __restrict__ A, const bf16_t* __restrict__ Bt, const int N, void* outp, const int ldo, char* smem, const int blk0 = 0) {
  const int tid = threadIdx.x, lane = tid & 63, w = tid >> 6, fr = lane & 15, fq = lane >> 4;
  constexpr int TW = 16 * NF;
  float* red = (float*)smem;
  const int nitems = 8 * (N / TW);
  constexpr int KW = K / 8;
  constexpr int KB = (NF == 2) ? 128 : 64;
  const int nblk = (int)gridDim.x - blk0;
  for (int it = (int)blockIdx.x - blk0; it >= 0 && it < nitems; it += nblk) {
    const int mi = it & 7, ni = it >> 3;
    const bf16_t* Ab = A + (size_t)(TP + mi * 64 + fr) * K + w * KW + fq * 8;
    const bf16_t* Bb = Bt + (size_t)(ni * TW + fr) * K + w * KW + fq * 8;
    f32x4 acc[4][NF];
#pragma unroll
    for (int i = 0; i < 4; ++i)
#pragma unroll
      for (int j = 0; j < NF; ++j) acc[i][j] = (f32x4){0.f, 0.f, 0.f, 0.f};
#pragma unroll 1
    for (int kb = 0; kb < KW; kb += KB) {
      bf16x8 af[KB / 32][4], bfv[KB / 32][NF];
#pragma unroll
      for (int ks = 0; ks < KB / 32; ++ks) {
#pragma unroll
        for (int mf = 0; mf < 4; ++mf) af[ks][mf] = *(const bf16x8*)(Ab + (size_t)(mf * 16) * K + kb + ks * 32);
#pragma unroll
        for (int nf = 0; nf < NF; ++nf) bfv[ks][nf] = *(const bf16x8*)(Bb + (size_t)(nf * 16) * K + kb + ks * 32);
      }
#pragma unroll
      for (int ks = 0; ks < KB / 32; ++ks)
#pragma unroll
        for (int mf = 0; mf < 4; ++mf)
#pragma unroll
          for (int nf = 0; nf < NF; ++nf)
            acc[mf][nf] = __builtin_amdgcn_mfma_f32_16x16x32_bf16(bfv[ks][nf], af[ks][mf], acc[mf][nf], 0, 0, 0);
    }
    __syncthreads();
#pragma unroll
    for (int mf = 0; mf < 4; ++mf)
#pragma unroll
      for (int nf = 0; nf < NF; ++nf)
        *(f32x4*)(red + ((w * 64 + mf * 16 + fr) * TW + (((nf * 4 + fq) ^ (fr & 7)) << 2))) = acc[mf][nf];
    __syncthreads();
    if (EPI == 3) {
      constexpr int GPT = TW / 32;
      for (int e = tid; e < 64 * GPT * 4; e += 512) {
        const int row = e / (GPT * 4), gq = e % (GPT * 4), gi = gq >> 2, c4 = (gq & 3) * 4;
        f32x4 a = {0.f, 0.f, 0.f, 0.f}, b = {0.f, 0.f, 0.f, 0.f};
#pragma unroll
        for (int ww = 0; ww < 8; ++ww) { a += *(const f32x4*)(red + ((ww * 64 + row) * TW + (((gi * 8 + (c4 >> 2)) ^ (row & 7)) << 2))); b += *(const f32x4*)(red + ((ww * 64 + row) * TW + (((gi * 8 + 4 + (c4 >> 2)) ^ (row & 7)) << 2))); }
        f32x4 o;
#pragma unroll
        for (int j = 0; j < 4; ++j) o[j] = a[j] / (1.0f + __expf(-b[j]));
        u32x2 pk; pk.x = cvt_pk_bf16(o[0], o[1]); pk.y = cvt_pk_bf16(o[2], o[3]);
        *(u32x2*)((bf16_t*)outp + (size_t)(TP + mi * 64 + row) * ldo + (ni * GPT + gi) * 16 + c4) = pk;
      }
    } else {
      for (int e = tid; e < 64 * (TW / 4); e += 512) {
        const int row = e / (TW / 4), c4 = (e % (TW / 4)) * 4;
        f32x4 v = {0.f, 0.f, 0.f, 0.f};
#pragma unroll
        for (int ww = 0; ww < 8; ++ww) v += *(const f32x4*)(red + ((ww * 64 + row) * TW + (((c4 >> 2) ^ (row & 7)) << 2)));
        const size_t o = (size_t)(TP + mi * 64 + row) * ldo + ni * TW + c4;
        if (EPI == 2) {
          *(f32x4*)((float*)outp + o) = v;
        } else {
          if (EPI == 1) {
#pragma unroll
            for (int j = 0; j < 4; ++j) { const float t = fmaxf(v[j], 0.f); v[j] = t * t; }
          }
          u32x2 pk; pk.x = cvt_pk_bf16(v[0], v[1]); pk.y = cvt_pk_bf16(v[2], v[3]);
          *(u32x2*)((bf16_t*)outp + o) = pk;
        }
      }
    }
  }
  __syncthreads();
}

__device__ __forceinline__ float gate_decay(float z) {
  const float ls = fminf(z, 0.f) - log1pf(expf(-fabsf(z)));
  return expf(ls * 0.0625f);
}

__device__ void gla_sample_item(const Params& p, const int item, char* smem, const int tid) {
  const int h = item & 3, b = item >> 2;
  float* wg = (float*)smem;
  float* bg = wg + 2048;
  float* gl_s = bg + 128;
  float* q_s = gl_s + 64;
  float* k_s = q_s + 512;
  float* e_s = k_s + 512;
  const bf16_t* proj = (const bf16_t*)p.big;
  const int tok0 = TP + b * 4;
  __syncthreads();
  for (int i = tid; i < 2048; i += 256) { const int r = i >> 7, k = i & 127; wg[i] = p.gla_w_gate_up[r * 512 + h * 128 + k]; }
  if (tid < 128) bg[tid] = p.gla_b_gate[h * 128 + tid];
  if (tid < 64) gl_s[tid] = bf2f(proj[(size_t)(tok0 + (tid >> 4)) * PS + 3072 + (tid & 15)]);
  for (int i = tid; i < 512; i += 256) {
    const int tt = i >> 7, k = i & 127;
    q_s[i] = bf2f(proj[(size_t)(tok0 + tt) * PS + h * 128 + k]) * 0.08838834764831845f;
    k_s[i] = bf2f(proj[(size_t)(tok0 + tt) * PS + 512 + h * 128 + k]);
  }
  float vr[4];
#pragma unroll
  for (int tt = 0; tt < 4; ++tt) vr[tt] = bf2f(proj[(size_t)(tok0 + tt) * PS + 1024 + h * 256 + tid]);
  __syncthreads();
  for (int i = tid; i < 512; i += 256) {
    const int tt = i >> 7, k = i & 127;
    float z = bg[k];
#pragma unroll
    for (int r = 0; r < 16; ++r) z += gl_s[tt * 16 + r] * wg[r * 128 + k];
    e_s[i] = gate_decay(z);
  }
  __syncthreads();
  const float* sin_ = p.state_gla + ((size_t)(b * 4 + h) * 128) * 256 + tid;
  float* sout = p.out + OFF_GLA_S + ((size_t)(b * 4 + h) * 128) * 256 + tid;
  float o[4] = {0.f, 0.f, 0.f, 0.f};
  for (int kb = 0; kb < 128; kb += 16) {
    float Sv[16];
#pragma unroll
    for (int i = 0; i < 16; ++i) Sv[i] = sin_[(size_t)(kb + i) * 256];
#pragma unroll
    for (int i = 0; i < 16; ++i) {
      const int k = kb + i;
#pragma unroll
      for (int tt = 0; tt < 4; ++tt) { Sv[i] = e_s[tt * 128 + k] * Sv[i] + k_s[tt * 128 + k] * vr[tt]; o[tt] += q_s[tt * 128 + k] * Sv[i]; }
    }
#pragma unroll
    for (int i = 0; i < 16; ++i) sout[(size_t)(kb + i) * 256] = Sv[i];
  }
#pragma unroll
  for (int tt = 0; tt < 4; ++tt) p.a1[(size_t)(tok0 + tt) * 1024 + h * 256 + tid] = f2bf(o[tt]);
}


constexpr size_t KT_OFF = (size_t)T * PS * 2;
constexpr size_t VEC_OFF = KT_OFF + (size_t)16777216;

__device__ void gla_prep(const Params& p, char* smem) {
  float* gl_s = (float*)smem;
  const int c = threadIdx.x;
  bf16_t* proj = (bf16_t*)p.big;
  bf16_t* KT = (bf16_t*)(p.big + KT_OFF);
  float* VEC = (float*)(p.big + VEC_OFF);
  float wg[16];
#pragma unroll
  for (int r = 0; r < 16; ++r) wg[r] = p.gla_w_gate_up[r * 512 + c];
  const float bias = p.gla_b_gate[c];
  for (int item = blockIdx.x; item < 256; item += gridDim.x) {
    const int tok0 = (item >> 5) * 2048 + (item & 31) * 64;
    __syncthreads();
    for (int i = threadIdx.x; i < 1024; i += 512) gl_s[i] = bf2f(proj[(size_t)(tok0 + (i >> 4)) * PS + 3072 + (i & 15)]);
    __syncthreads();
    float bc[64]; float run = 0.f;
#pragma unroll
    for (int t = 0; t < 64; ++t) {
      float z = bias;
#pragma unroll
      for (int r = 0; r < 16; ++r) z += gl_s[t * 16 + r] * wg[r];
      const float ls = fminf(z, 0.f) - __logf(1.0f + __expf(-fabsf(z)));
      run += ls * 0.0625f; bc[t] = run;
    }
    const float bref = bc[32], blast = bc[63];
    bf16_t* qp = proj + (size_t)tok0 * PS + c;
    bf16_t* kp = qp + 512;
    bf16_t* ktp = KT + ((size_t)(item * 4 + (c >> 7)) * 128 + (c & 127)) * 64;
#pragma unroll
    for (int t8 = 0; t8 < 8; ++t8) {
      float kk[8];
#pragma unroll
      for (int i = 0; i < 8; ++i) {
        const int t = t8 * 8 + i;
        const float q = bf2f(qp[(size_t)t * PS]), k = bf2f(kp[(size_t)t * PS]);
        const float qi = q * 0.08838834764831845f * __expf(bc[t] - bref);
        kk[i] = k * __expf(bref - bc[t]);
        qp[(size_t)t * PS] = f2bf(qi);
        kp[(size_t)t * PS] = f2bf(kk[i]);
      }
      u32x4 w; w.x = cvt_pk_bf16(kk[0], kk[1]); w.y = cvt_pk_bf16(kk[2], kk[3]); w.z = cvt_pk_bf16(kk[4], kk[5]); w.w = cvt_pk_bf16(kk[6], kk[7]);
      *(u32x4*)(ktp + t8 * 8) = w;
    }
    VEC[(size_t)(item * 3 + 0) * 512 + c] = __expf(bref);
    VEC[(size_t)(item * 3 + 1) * 512 + c] = __expf(blast - bref);
    VEC[(size_t)(item * 3 + 2) * 512 + c] = __expf(blast);
  }
}

__device__ __forceinline__ bf16x8 lfrag(const char* base, int row, int rowbytes, int chunk, int mask) {
  return *(const bf16x8*)(base + row * rowbytes + ((chunk ^ (row & mask)) << 4));
}

__device__ __forceinline__ bf16x8 lfragV(const char* base, int row, int chunk) {
  return *(const bf16x8*)(base + row * 128 + ((chunk ^ (row & 7) ^ ((row >> 3) & 7)) << 4));
}

struct GlaRegs { u32x4 q[2], k[2], t[2], v; float c; };

__device__ void gla_main_item(const Params& p, const int item, char* smem) {
  const int b = item >> 4, h = (item >> 2) & 3, v0 = (item & 3) * 64;
  const int tid = threadIdx.x, lane = tid & 63, w = tid >> 6, fr = lane & 15, fq = lane >> 4;
  char* Qs = smem;
  char* Ks = smem + 16384;
  char* KTs = smem + 32768;
  char* VTs = smem + 49152;
  char* ATs = smem + 57344;
  char* HTs = smem + 65536;
  float* VCs = (float*)(smem + 81920);
  const bf16_t* proj = (const bf16_t*)p.big;
  const bf16_t* KT = (const bf16_t*)(p.big + KT_OFF);
  const float* VEC = (const float*)(p.big + VEC_OFF);
  f32x4 hacc[4];
#pragma unroll
  for (int i = 0; i < 4; ++i) hacc[i] = (f32x4){0.f, 0.f, 0.f, 0.f};
  const int qrow0 = tid >> 4, qch = tid & 15;
  const int trow0 = tid >> 3, tch = tid & 7;
  const int vt_t = tid >> 3, vt_v = (tid & 7) * 8;
  auto load_regs = [&](const int n, GlaRegs& R) {
    const int tok0 = b * 2048 + n * 64, ci = b * 32 + n;
#pragma unroll
    for (int i = 0; i < 2; ++i) {
      const bf16_t* r = proj + (size_t)(tok0 + qrow0 + 32 * i) * PS + h * 128 + qch * 8;
      R.q[i] = *(const u32x4*)r; R.k[i] = *(const u32x4*)(r + 512);
      R.t[i] = *(const u32x4*)(KT + ((size_t)(ci * 4 + h) * 128 + trow0 + 64 * i) * 64 + tch * 8);
    }
    R.v = *(const u32x4*)(proj + (size_t)(tok0 + vt_t) * PS + 1024 + h * 256 + v0 + vt_v);
    R.c = (tid < 384) ? VEC[(size_t)(ci * 3 + (tid >> 7)) * 512 + h * 128 + (tid & 127)] : 0.f;
  };
  auto store_regs = [&](const GlaRegs& R) {
#pragma unroll
    for (int i = 0; i < 2; ++i) {
      const int r = qrow0 + 32 * i;
      *(u32x4*)(Qs + r * 256 + ((qch ^ (r & 15)) << 4)) = R.q[i]; *(u32x4*)(Ks + r * 256 + ((qch ^ (r & 15)) << 4)) = R.k[i];
      const int k = trow0 + 64 * i; *(u32x4*)(KTs + k * 128 + ((tch ^ (k & 7)) << 4)) = R.t[i];
    }
    const unsigned wv[4] = {R.v.x, R.v.y, R.v.z, R.v.w};
#pragma unroll
    for (int i = 0; i < 8; ++i) {
      const int v = vt_v + i;
      *(bf16_t*)(VTs + v * 128 + (((vt_t >> 3) ^ (v & 7) ^ ((v >> 3) & 7)) << 4) + (vt_t & 7) * 2) = (bf16_t)((wv[i >> 1] >> ((i & 1) * 16)) & 0xffffu);
    }
    if (tid < 384) VCs[tid] = R.c;
  };
  auto body = [&](const int n) {
    const int tok0 = b * 2048 + n * 64;
    {
      const int k = w * 16 + fq * 4;
      const f32x4 er = *(const f32x4*)(VCs + k);
#pragma unroll
      for (int vt = 0; vt < 4; ++vt) {
        const int v = vt * 16 + fr;
        u32x2 pk; pk.x = cvt_pk_bf16(hacc[vt][0] * er[0], hacc[vt][1] * er[1]); pk.y = cvt_pk_bf16(hacc[vt][2] * er[2], hacc[vt][3] * er[3]);
        *(u32x2*)(HTs + v * 256 + (((k >> 3) ^ (v & 15)) << 4) + (k & 7) * 2) = pk;
      }
    }
    {
      const int tt = w >> 1, st0 = (w & 1) * 2;
      f32x4 d[2] = {(f32x4){0.f, 0.f, 0.f, 0.f}, (f32x4){0.f, 0.f, 0.f, 0.f}};
#pragma unroll
      for (int ks = 0; ks < 4; ++ks) {
        const bf16x8 qf = lfrag(Qs, tt * 16 + fr, 256, ks * 4 + fq, 15);
#pragma unroll
        for (int s2 = 0; s2 < 2; ++s2) {
          const bf16x8 kf = lfrag(Ks, (st0 + s2) * 16 + fr, 256, ks * 4 + fq, 15);
          d[s2] = __builtin_amdgcn_mfma_f32_16x16x32_bf16(kf, qf, d[s2], 0, 0, 0);
        }
      }
      const int t = tt * 16 + fr;
#pragma unroll
      for (int s2 = 0; s2 < 2; ++s2) {
        const int s = (st0 + s2) * 16 + fq * 4;
        const float a0 = (s + 0 <= t) ? d[s2][0] : 0.f, a1 = (s + 1 <= t) ? d[s2][1] : 0.f, a2 = (s + 2 <= t) ? d[s2][2] : 0.f, a3 = (s + 3 <= t) ? d[s2][3] : 0.f;
        u32x2 pk; pk.x = cvt_pk_bf16(a0, a1); pk.y = cvt_pk_bf16(a2, a3);
        *(u32x2*)(ATs + t * 128 + (((s >> 3) ^ (t & 7)) << 4) + (s & 7) * 2) = pk;
      }
    }
    __syncthreads();
    {
      const int tt = w >> 1, vt0 = (w & 1) * 2;
      f32x4 o[2] = {(f32x4){0.f, 0.f, 0.f, 0.f}, (f32x4){0.f, 0.f, 0.f, 0.f}};
#pragma unroll
      for (int ks = 0; ks < 2; ++ks) {
        const bf16x8 af = lfrag(ATs, tt * 16 + fr, 128, ks * 4 + fq, 7);
#pragma unroll
        for (int v2 = 0; v2 < 2; ++v2) o[v2] = __builtin_amdgcn_mfma_f32_16x16x32_bf16(lfragV(VTs, (vt0 + v2) * 16 + fr, ks * 4 + fq), af, o[v2], 0, 0, 0);
      }
#pragma unroll
      for (int ks = 0; ks < 4; ++ks) {
        const bf16x8 qf = lfrag(Qs, tt * 16 + fr, 256, ks * 4 + fq, 15);
#pragma unroll
        for (int v2 = 0; v2 < 2; ++v2) o[v2] = __builtin_amdgcn_mfma_f32_16x16x32_bf16(lfrag(HTs, (vt0 + v2) * 16 + fr, 256, ks * 4 + fq, 15), qf, o[v2], 0, 0, 0);
      }
#pragma unroll
      for (int v2 = 0; v2 < 2; ++v2) {
        u32x2 pk; pk.x = cvt_pk_bf16(o[v2][0], o[v2][1]); pk.y = cvt_pk_bf16(o[v2][2], o[v2][3]);
        *(u32x2*)(p.a1 + (size_t)(tok0 + tt * 16 + fr) * 1024 + h * 256 + v0 + (vt0 + v2) * 16 + fq * 4) = pk;
      }
    }
    {
      const int k = w * 16 + fq * 4;
      const f32x4 ec = *(const f32x4*)(VCs + 128 + k), dc = *(const f32x4*)(VCs + 256 + k);
      f32x4 u[4];
#pragma unroll
      for (int vt = 0; vt < 4; ++vt) u[vt] = (f32x4){0.f, 0.f, 0.f, 0.f};
#pragma unroll
      for (int ks = 0; ks < 2; ++ks) {
        const bf16x8 kf = lfrag(KTs, w * 16 + fr, 128, ks * 4 + fq, 7);
#pragma unroll
        for (int vt = 0; vt < 4; ++vt) u[vt] = __builtin_amdgcn_mfma_f32_16x16x32_bf16(kf, lfragV(VTs, vt * 16 + fr, ks * 4 + fq), u[vt], 0, 0, 0);
      }
#pragma unroll
      for (int vt = 0; vt < 4; ++vt)
#pragma unroll
        for (int j = 0; j < 4; ++j) hacc[vt][j] = dc[j] * hacc[vt][j] + ec[j] * u[vt][j];
    }
  };
  GlaRegs RA, RB;
  __syncthreads();
  load_regs(0, RA);
  store_regs(RA);
  __syncthreads();
  load_regs(1, RA);
  for (int n = 0; n < 32; n += 2) {
    if (n + 2 < 32) load_regs(n + 2, RB);
    body(n);
    __syncthreads();
    store_regs(RA);
    __syncthreads();
    if (n + 3 < 32) load_regs(n + 3, RA);
    body(n + 1);
    __syncthreads();
    if (n + 2 < 32) store_regs(RB);
    __syncthreads();
  }
  float* st = p.out + OFF_GLA_P + ((size_t)(b * 4 + h) * 128) * 256;
#pragma unroll
  for (int vt = 0; vt < 4; ++vt)
#pragma unroll
    for (int j = 0; j < 4; ++j) st[(size_t)(w * 16 + fq * 4 + j) * 256 + v0 + vt * 16 + fr] = hacc[vt][j];
}

__device__ void gla_phase(const Params& p, char* smem) {
  const int sub = threadIdx.x >> 8, tid = threadIdx.x & 255;
  const int G = (int)gridDim.x;
  if (G >= 256) {
    if ((int)blockIdx.x < 128) gla_main_item(p, blockIdx.x, smem);
    else for (int base = ((int)blockIdx.x - 128) * 2; base < 512; base += (G - 128) * 2) gla_sample_item(p, base + sub, smem + sub * 65536, tid);
  } else {
    for (int item = blockIdx.x; item < 128; item += G) gla_main_item(p, item, smem);
    for (int base = blockIdx.x * 2; base < 512; base += G * 2) gla_sample_item(p, base + sub, smem + sub * 65536, tid);
  }
}

__device__ void gla_gate_rows(const Params& p) {
  const int lane = threadIdx.x & 63, wid = threadIdx.x >> 6;
  const bf16_t* proj = (const bf16_t*)p.big;
  const int nwav = gridDim.x * 8;
  f32x4 g[4];
#pragma unroll
  for (int i = 0; i < 4; ++i) g[i] = *(const f32x4*)(p.gla_g_head + i * 256 + lane * 4);
  for (int row0 = blockIdx.x * 8 + wid; row0 < T; row0 += 2 * nwav) {
    u32x2 ow[2][4], rw[2][4]; bool ok[2];
#pragma unroll
    for (int r = 0; r < 2; ++r) {
      const int row = row0 + r * nwav; ok[r] = row < T;
      if (ok[r]) {
#pragma unroll
        for (int i = 0; i < 4; ++i) { ow[r][i] = *(const u32x2*)(p.a1 + (size_t)row * 1024 + i * 256 + lane * 4); rw[r][i] = *(const u32x2*)(proj + (size_t)row * PS + 2048 + i * 256 + lane * 4); }
      }
    }
#pragma unroll
    for (int r = 0; r < 2; ++r) {
      if (!ok[r]) continue;
      const int row = row0 + r * nwav;
#pragma unroll
      for (int i = 0; i < 4; ++i) {
        const float o[4] = {bflo(ow[r][i].x), bfhi(ow[r][i].x), bflo(ow[r][i].y), bfhi(ow[r][i].y)};
        float ss = o[0] * o[0] + o[1] * o[1] + o[2] * o[2] + o[3] * o[3];
        ss = wave_sum(ss);
        const float rs = rsqrtf(ss * (1.0f / 256.0f) + EPS);
        const float rr[4] = {bflo(rw[r][i].x), bfhi(rw[r][i].x), bflo(rw[r][i].y), bfhi(rw[r][i].y)};
        float y[4];
#pragma unroll
        for (int j = 0; j < 4; ++j) y[j] = o[j] * rs * g[i][j] * (rr[j] / (1.0f + __expf(-rr[j])));
        u32x2 w; w.x = cvt_pk_bf16(y[0], y[1]); w.y = cvt_pk_bf16(y[2], y[3]);
        *(u32x2*)(p.a1 + (size_t)row * 1024 + i * 256 + lane * 4) = w;
      }
    }
  }
}

__device__ __forceinline__ bf16x8 pack8(const float* s, float sgn) {
  const f32x4 a = *(const f32x4*)s, b = *(const f32x4*)(s + 4);
  union { u32x4 u; bf16x8 v; } r;
  r.u.x = cvt_pk_bf16(a[0] * sgn, a[1] * sgn); r.u.y = cvt_pk_bf16(a[2] * sgn, a[3] * sgn);
  r.u.z = cvt_pk_bf16(b[0] * sgn, b[1] * sgn); r.u.w = cvt_pk_bf16(b[2] * sgn, b[3] * sgn);
  return r.v;
}

struct S5Consts { bf16x8 Bb[8]; bf16x8 Cc[4]; float lr, li, dsk; };

__device__ __forceinline__ void s5_load_consts(const Params& p, const int g, const int lane, S5Consts& k) {
  const int fr = lane & 15, fq = lane >> 4;
  const bf16x8 zero8 = {0, 0, 0, 0, 0, 0, 0, 0};
#pragma unroll
  for (int nt = 0; nt < 8; ++nt) {
    const int pp = nt * 8 + (fr >> 1);
    const float* src = p.bb + ((fr & 1) ? 65536 : 0) + (size_t)(g * 64 + pp) * 16 + (fq & 1) * 8;
    const bf16x8 v = pack8(src, 1.0f);
    k.Bb[nt] = (fq < 2) ? v : zero8;
  }
#pragma unroll
  for (int ks = 0; ks < 4; ++ks) {
    const int p0 = ks * 16 + fq * 4;
    const f32x4 cr = *(const f32x4*)(p.s5_c_re + (size_t)(g * 16 + fr) * 64 + p0), ci = *(const f32x4*)(p.s5_c_im + (size_t)(g * 16 + fr) * 64 + p0);
    union { u32x4 u; bf16x8 v; } r;
    r.u.x = cvt_pk_bf16(cr[0], -ci[0]); r.u.y = cvt_pk_bf16(cr[1], -ci[1]); r.u.z = cvt_pk_bf16(cr[2], -ci[2]); r.u.w = cvt_pk_bf16(cr[3], -ci[3]);
    k.Cc[ks] = r.v;
  }
  k.lr = p.lam[g * 64 + lane]; k.li = p.lam[4096 + g * 64 + lane];
  k.dsk = p.s5_d[g * 16 + fr];
}

template <bool FULL>
__device__ __forceinline__ void s5_segment(const Params& p, const S5Consts& k, const int tok0, const int L, const int g, float& hr, float& hi,
                                           char* wl, const int lane) {
  const int fr = lane & 15, fq = lane >> 4;
  float* bu_s = (float*)wl;
  bf16_t* h_s = (bf16_t*)(wl + 8448);
  bf16_t* u_s = (bf16_t*)(wl + 12800);
  const bf16_t* u = (const bf16_t*)p.big;
  const u32x4 zero4 = {0u, 0u, 0u, 0u};
  const bf16_t* ub = u + (size_t)(tok0 + fr) * 1024 + g * 16 + (fq & 1) * 8;
#define S5_LD(c) ((fq < 2 && (c) + fr < L) ? *(const u32x4*)(ub + (size_t)(c) * 1024) : zero4)
  u32x4 q0 = S5_LD(0), q1 = S5_LD(16), q2 = S5_LD(32), q3 = S5_LD(48);
  for (int c0 = 0; c0 < L; c0 += 16) {
    const u32x4 cur = q0; q0 = q1; q1 = q2; q2 = q3; q3 = S5_LD(c0 + 64);
    union { u32x4 u4; bf16x8 v; } ua; ua.u4 = cur;
#pragma unroll
    for (int nt = 0; nt < 8; ++nt) {
      const f32x4 d = __builtin_amdgcn_mfma_f32_16x16x32_bf16(ua.v, k.Bb[nt], (f32x4){0.f, 0.f, 0.f, 0.f}, 0, 0, 0);
#pragma unroll
      for (int j = 0; j < 4; ++j) bu_s[(fq * 4 + j) * 132 + nt * 16 + fr] = d[j];
    }
    if (FULL && fq < 2) *(u32x4*)(u_s + fr * 16 + fq * 8) = cur;
    lds_fence();
    const int nsteps = (L - c0) < 16 ? (L - c0) : 16;
    f32x2 bu[16];
#pragma unroll
    for (int tt = 0; tt < 16; ++tt) bu[tt] = *(const f32x2*)(bu_s + tt * 132 + 2 * lane);
#pragma unroll
    for (int tt = 0; tt < 16; ++tt) {
      if (tt < nsteps) {
        const float nr = k.lr * hr - k.li * hi + bu[tt][0];
        const float ni = k.lr * hi + k.li * hr + bu[tt][1];
        hr = nr; hi = ni;
      }
      if (FULL) ((unsigned*)h_s)[tt * 68 + lane] = cvt_pk_bf16(hr, hi);
    }
    lds_fence();
    if (FULL) {
      f32x4 y = {0.f, 0.f, 0.f, 0.f};
#pragma unroll
      for (int ks = 0; ks < 4; ++ks) {
        const bf16x8 ha = *(const bf16x8*)(h_s + fr * 136 + ks * 32 + fq * 8);
        y = __builtin_amdgcn_mfma_f32_16x16x32_bf16(ha, k.Cc[ks], y, 0, 0, 0);
      }
#pragma unroll
      for (int j = 0; j < 4; ++j) {
        const int tt = fq * 4 + j;
        if (c0 + tt < L) {
          const float yy = y[j] + k.dsk * bf2f(u_s[tt * 16 + fr]);
          const float z = yy / (1.0f + __expf(-1.5957691216057308f * (yy + 0.044715f * yy * yy * yy)));
          p.a1[(size_t)(tok0 + c0 + tt) * 1024 + g * 16 + fr] = f2bf(z);
        }
      }
      lds_fence();
    }
  }
#undef S5_LD
}

__device__ void s5_phase(const Params& p, char* smem) {
  const int tid = threadIdx.x, lane = tid & 63, wid = tid >> 6;
  char* wl = smem + wid * 14336;
  float* carry = (float*)(smem + 114688);
  for (int pb = blockIdx.x * 2; pb < 512; pb += gridDim.x * 2) {
    const int pl = wid >> 2, seg = wid & 3, pair = pb + pl;
    const int b = pair >> 6, g = pair & 63;
    const int tok0 = b * 2048 + seg * 512;
    S5Consts k; s5_load_consts(p, g, lane, k);
    float hr = 0.f, hi = 0.f;
    s5_segment<false>(p, k, tok0, 512, g, hr, hi, wl, lane);
    __syncthreads();
    carry[((pl * 4 + seg) * 2 + 0) * 64 + lane] = hr; carry[((pl * 4 + seg) * 2 + 1) * 64 + lane] = hi;
    __syncthreads();
    float pr = k.lr, pi = k.li;
#pragma unroll
    for (int i = 0; i < 9; ++i) { const float tr = pr * pr - pi * pi, ti = 2.0f * pr * pi; pr = tr; pi = ti; }
    hr = 0.f; hi = 0.f;
    for (int s2 = 0; s2 < seg; ++s2) {
      const float fr_ = carry[((pl * 4 + s2) * 2 + 0) * 64 + lane], fi_ = carry[((pl * 4 + s2) * 2 + 1) * 64 + lane];
      const float nr = pr * hr - pi * hi + fr_, ni = pr * hi + pi * hr + fi_;
      hr = nr; hi = ni;
    }
    s5_segment<true>(p, k, tok0, 512, g, hr, hi, wl, lane);
    if (seg == 3) {
      p.out[OFF_S5RP + (size_t)(b * 64 + g) * 64 + lane] = hr; p.out[OFF_S5IP + (size_t)(b * 64 + g) * 64 + lane] = hi;
    }
    __syncthreads();
  }
  const int gw = wid * gridDim.x + blockIdx.x, nw = gridDim.x * 8;
  const bool same_g = (nw & 63) == 0;
  S5Consts ks;
  if (same_g && gw < 8192) s5_load_consts(p, gw & 63, lane, ks);
  for (int it = gw; it < 8192; it += nw) {
    const int b = it >> 6, g = it & 63;
    if (!same_g) s5_load_consts(p, g, lane, ks);
    float hr = p.s5_re[(size_t)(b * 64 + g) * 64 + lane], hi = p.s5_im[(size_t)(b * 64 + g) * 64 + lane];
    s5_segment<true>(p, ks, TP + b * 4, 4, g, hr, hi, wl, lane);
    p.out[OFF_S5RS + (size_t)(b * 64 + g) * 64 + lane] = hr; p.out[OFF_S5IS + (size_t)(b * 64 + g) * 64 + lane] = hi;
  }
}

#define XB_TMO      128
#define XB_XCNT(j)  (256  + 64 * (j))
#define XB_XSUB(j)  (1280 + 64 * (j))
#define XB_XGEN(j)  (2304 + 64 * (j))
#define XB_TOP      3328
#define XB_TOPGEN   3392
#define XCD_BAR_WORDS 3456
#define XB_SPIN_CAP (1u << 18)
__device__ __forceinline__ unsigned xb_ld(unsigned* p)              { return __hip_atomic_load(p, __ATOMIC_RELAXED, __HIP_MEMORY_SCOPE_AGENT); }
__device__ __forceinline__ unsigned xb_add(unsigned* p, unsigned v) { return __hip_atomic_fetch_add(p, v, __ATOMIC_RELAXED, __HIP_MEMORY_SCOPE_AGENT); }
__device__ __forceinline__ unsigned xb_xcc_id() { return (unsigned)__builtin_amdgcn_s_getreg((3 << 11) | 20) & 0xFu; }
#define XB_SPIN(cond, bar) do { unsigned _sp = 0; while (cond) { __builtin_amdgcn_s_sleep(1); \
    if ((++_sp & 255u) == 0u) { if (xb_ld(&(bar)[XB_TMO])) break; if (_sp > XB_SPIN_CAP) { atomicAdd(&(bar)[XB_TMO], 1u); break; } } } } while (0)
struct XcdBarrier { unsigned* bar; unsigned x; volatile LAS unsigned* st; };
__device__ __forceinline__ XcdBarrier xcd_barrier_post(unsigned* bar, volatile LAS unsigned* st) {
  XcdBarrier b; b.bar = bar; b.x = xb_xcc_id(); b.st = st;
  if (threadIdx.x == 0) (void)xb_add(&bar[XB_XCNT(b.x)], 1u);
  return b;
}
__device__ __forceinline__ void xcd_barrier_complete(unsigned* bar, unsigned x, unsigned& nloc, unsigned& nx) {
  const unsigned G = gridDim.x * gridDim.y * gridDim.z;
  unsigned sum, cnt, mine, sp = 0u;
  for (;;) {
    sum = 0u; cnt = 0u; mine = 0u;
#pragma unroll
    for (unsigned j = 0; j < 16; ++j) { const unsigned c = xb_ld(&bar[XB_XCNT(j)]); sum += c; cnt += (c > 0u) ? 1u : 0u; mine = (j == x) ? c : mine; }
    if (sum == G) break;
    __builtin_amdgcn_s_sleep(1);
    if ((++sp & 255u) == 0u) { if (xb_ld(&bar[XB_TMO])) break; if (sp > XB_SPIN_CAP) { atomicAdd(&bar[XB_TMO], 1u); break; } }
  }
  nloc = mine > 0u ? mine : 1u; nx = cnt > 0u ? cnt : 1u;
}
__device__ __forceinline__ void xcd_barrier(const XcdBarrier& b) {
  asm volatile("s_waitcnt vmcnt(0)" ::: "memory");
  __syncthreads();
  if (threadIdx.x == 0) {
    unsigned* bar = b.bar;
    __builtin_amdgcn_s_waitcnt(0);
    unsigned nloc = b.st[0], nx = b.st[1];
    if (nloc == 0u) { xcd_barrier_complete(bar, b.x, nloc, nx); b.st[0] = nloc; b.st[1] = nx; }
    const unsigned old = xb_add(&bar[XB_XSUB(b.x)], 1u);
    const unsigned gen = old / nloc;
    if (old + 1u == (gen + 1u) * nloc) {
      __builtin_amdgcn_fence(__ATOMIC_RELEASE, "agent");
      asm volatile("s_waitcnt vmcnt(0)" ::: "memory");
      const unsigned og = xb_add(&bar[XB_TOP], 1u);
      const unsigned tg = og / nx;
      if (og + 1u == (tg + 1u) * nx) xb_add(&bar[XB_TOPGEN], 1u);
      else XB_SPIN(xb_ld(&bar[XB_TOPGEN]) == tg, bar);
      __builtin_amdgcn_fence(__ATOMIC_ACQUIRE, "agent");
      xb_add(&bar[XB_XGEN(b.x)], 1u);
      asm volatile("s_waitcnt vmcnt(0)" ::: "memory");
    } else {
      XB_SPIN(xb_ld(&bar[XB_XGEN(b.x)]) == gen, bar);
      __builtin_amdgcn_fence(__ATOMIC_ACQUIRE, "agent");
      asm volatile("s_waitcnt vmcnt(0)" ::: "memory");
    }
  }
  __syncthreads();
}
#define grid_sync() xcd_barrier(xbar)

#ifndef DOUBLE_MASK
#define DOUBLE_MASK 0
#endif
#define PHASE(k, call) \
  if (p.phase_lo <= (k) && (k) < p.phase_hi) { if ((DOUBLE_MASK >> (k)) & 1) { call; grid_sync(); } call; if ((k) + 1 < p.phase_hi) grid_sync(); }

#define STAGGER(main_call, sample_call) \
  [&]() { if (blockIdx.x & 1) { sample_call; main_call; } else { main_call; sample_call; } }()

__global__ void __launch_bounds__(512, 2) mega_kernel(Params p) {
  extern __shared__ __attribute__((aligned(16))) char smem[];
  LAS unsigned char* lds = (LAS unsigned char*)smem;
  volatile LAS unsigned* xst = (volatile LAS unsigned*)(lds + 131072);
  if (threadIdx.x < 4) xst[threadIdx.x] = 0u;
  __syncthreads();
  const XcdBarrier xbar = xcd_barrier_post(p.bar, xst);
  if (p.phase_lo == 12345) cg::this_grid().sync();
  PHASE(0, (transpose_tiles(p, smem), s5_consts(p), norm0_rows(p)))
  PHASE(1, (gemm_phase<0>(lds, p.a1, p.wt_gla_in, TP, PS, 1024, p.big, PS), sgemm_sample<0, 1024>(p.a1, p.wt_gla_in, PS, p.big, PS, smem, (gridDim.x == 256) ? 64 : 0)))
  PHASE(2, (gla_prep(p, smem), __syncthreads()))
  PHASE(3, gla_phase(p, smem))
  PHASE(4, gla_gate_rows(p))
  PHASE(5, (gemm_phase<0>(lds, p.a1, p.wt_gla_out, TP, 1024, 1024, p.big, 1024), sgemm_sample<0, 1024>(p.a1, p.wt_gla_out, 1024, p.big, 1024, smem)))
  PHASE(6, rows_update(p, (const bf16_t*)p.big, p.g_post_mix, p.g_pre_mlp))
  PHASE(7, STAGGER((gemm_phase<1>(lds, p.a1, p.wt_up, TP, 4096, 1024, p.big, 4096)), (sgemm_sample<1, 1024, 4>(p.a1, p.wt_up, 4096, p.big, 4096, smem))))
  PHASE(8, (gemm_phase<0>(lds, (const bf16_t*)p.big, p.wt_down, TP, 1024, 4096, p.a1, 1024), sgemm_sample<0, 4096>((const bf16_t*)p.big, p.wt_down, 1024, p.a1, 1024, smem)))
  PHASE(9, rows_update(p, p.a1, p.g_post_mlp, p.g_pre_mix + 1024))
  PHASE(10, (gemm_phase<0>(lds, p.a1, p.wt_s5_in, TP, 1024, 1024, p.big, 1024), sgemm_sample<0, 1024>(p.a1, p.wt_s5_in, 1024, p.big, 1024, smem)))
  PHASE(11, s5_phase(p, smem))
  PHASE(12, STAGGER((gemm_phase<3>(lds, p.a1, p.wt_glu, TP, 2048, 1024, p.big, 1024)), (sgemm_sample<3, 1024, 4>(p.a1, p.wt_glu, 2048, p.big, 1024, smem))))
  PHASE(13, rows_update(p, (const bf16_t*)p.big, p.g_post_mix + 1024, p.g_pre_mlp + 1024))
  PHASE(14, STAGGER((gemm_phase<1>(lds, p.a1, p.wt_up + (size_t)4096 * 1024, TP, 4096, 1024, p.big, 4096)), (sgemm_sample<1, 1024, 4>(p.a1, p.wt_up + (size_t)4096 * 1024, 4096, p.big, 4096, smem))))
  PHASE(15, (gemm_phase<0>(lds, (const bf16_t*)p.big, p.wt_down + (size_t)4096 * 1024, TP, 1024, 4096, p.a1, 1024), sgemm_sample<0, 4096>((const bf16_t*)p.big, p.wt_down + (size_t)4096 * 1024, 1024, p.a1, 1024, smem)))
  PHASE(16, rows_update(p, p.a1, p.g_post_mlp + 1024, nullptr))
}

extern "C" void kernel_launch(void* const* d_in, const int* in_sizes, int n_in, void* d_out, int out_size, void* d_ws,
                              size_t ws_size, hipStream_t stream) {
  (void)in_sizes; (void)n_in; (void)out_size; (void)ws_size;
  Params p{};
  p.x_prompt = (const float*)d_in[0]; p.x_sample = (const float*)d_in[1]; p.state_gla = (const float*)d_in[2];
  p.s5_re = (const float*)d_in[3]; p.s5_im = (const float*)d_in[4];
  p.g_pre_mix = (const float*)d_in[5]; p.g_post_mix = (const float*)d_in[6]; p.g_pre_mlp = (const float*)d_in[7]; p.g_post_mlp = (const float*)d_in[8];
  p.w_up = (const float*)d_in[9]; p.w_down = (const float*)d_in[10]; p.gla_w_in = (const float*)d_in[11];
  p.gla_w_gate_up = (const float*)d_in[12]; p.gla_b_gate = (const float*)d_in[13]; p.gla_g_head = (const float*)d_in[14]; p.gla_w_out = (const float*)d_in[15];
  p.s5_w_in = (const float*)d_in[16]; p.s5_a_re = (const float*)d_in[17]; p.s5_a_im = (const float*)d_in[18]; p.s5_log_step = (const float*)d_in[19];
  p.s5_b_re = (const float*)d_in[20]; p.s5_b_im = (const float*)d_in[21]; p.s5_c_re = (const float*)d_in[22]; p.s5_c_im = (const float*)d_in[23];
  p.s5_d = (const float*)d_in[24]; p.s5_glu_a = (const float*)d_in[25]; p.s5_glu_b = (const float*)d_in[26];
  p.out = (float*)d_out;
  char* ws = (char*)d_ws;
  p.wt_gla_in = (bf16_t*)(ws + 0);
  p.wt_gla_out = (bf16_t*)(ws + 6815744);
  p.wt_up = (bf16_t*)(ws + 8912896);
  p.wt_down = (bf16_t*)(ws + 25690112);
  p.wt_s5_in = (bf16_t*)(ws + 42467328);
  p.wt_glu = (bf16_t*)(ws + 44564480);
  p.lam = (float*)(ws + 48758784);
  p.bb = (float*)(ws + 48791552);
  p.a1 = (bf16_t*)(ws + 49315840);
  p.big = ws + 83918848;
  p.bar = (unsigned*)(ws + 222330880);
  p.xr = (bf16_t*)(ws + 222344704);

  static int grid_blocks = 0;
  if (!grid_blocks) {
    int dev = 0, cus = 0, per_cu = 0;
    (void)hipGetDevice(&dev);
    (void)hipDeviceGetAttribute(&cus, hipDeviceAttributeMultiprocessorCount, dev);
    (void)hipFuncSetAttribute((const void*)mega_kernel, hipFuncAttributeMaxDynamicSharedMemorySize, LDS_BYTES);
    (void)hipOccupancyMaxActiveBlocksPerMultiprocessor(&per_cu, mega_kernel, 512, LDS_BYTES);
    if (per_cu > 1) per_cu = 1;
    if (per_cu < 1) per_cu = 1;
    if (cus <= 0) cus = 256;
    grid_blocks = cus * per_cu;
  }
#if ONE_LAUNCH
  p.phase_lo = 0; p.phase_hi = NPHASE;
  (void)hipMemsetAsync(p.bar, 0, XCD_BAR_WORDS * 4, stream);
  void* args[] = {&p};
  hipError_t e = hipLaunchCooperativeKernel((void*)mega_kernel, dim3(grid_blocks), dim3(512), args, LDS_BYTES, stream);
  if (e != hipSuccess) fprintf(stderr, "cooperative launch failed: %s (grid %d)\n", hipGetErrorString(e), grid_blocks);
#endif
}
```
